# Optimizing an MI355X kernel written in HIP

```python
import math
import jax
import jax.numpy as jnp
from jax import lax
import numpy as np

D_MODEL = 1024
BATCH = 4
SEQ = 8192
DEPTH = 1

GRID_W = 64
CTX_LEN = 256
EPS = 1e-6
N_MOD = 6

GDN_HEADS = 8
GDN_DK = 128
GDN_DV = 128
GDN_CONV = 5
GDN_CHUNK = 64
DT_MIN = 0.001
DT_MAX = 0.1
GDN_QKV_W = GDN_HEADS * (2 * GDN_DK + GDN_DV)

MLA_HEADS = 8
MLA_Q_LORA = 384
MLA_KV_LORA = 256
MLA_NOPE = 128
MLA_ROPE = 64
MLA_V = 128
MLA_QK = MLA_NOPE + MLA_ROPE
Q_BLOCK = 128
ROPE_THETA = 10000.0
ROPE_AXIS = MLA_ROPE // 2
ROPE_FREQS = ROPE_AXIS // 2

D_FF = 4 * D_MODEL
N_BRANCH = 2

IN_SPLITS = (GDN_QKV_W, GDN_HEADS * GDN_DV, 2 * GDN_HEADS, 2 * GDN_HEADS,
             MLA_Q_LORA, MLA_KV_LORA, MLA_ROPE, N_BRANCH * D_MODEL)
IN_COLS = sum(IN_SPLITS)

kernel_name = 'hybrid_gdn_mla_dit_layer'


def _rms(x, w):
    xf = x.astype(jnp.float32)
    y = xf * lax.rsqrt(jnp.mean(xf * xf, axis=-1, keepdims=True) + EPS)
    return y.astype(x.dtype) * w


def _l2norm(x):
    xf = x.astype(jnp.float32)
    return (xf * lax.rsqrt(jnp.sum(xf * xf, axis=-1, keepdims=True) + EPS)).astype(x.dtype)


def _modulate(xn, shift, scale):
    return xn * (1.0 + scale) + shift


def _split_in(proj):
    offsets = np.cumsum(IN_SPLITS)[:-1].tolist()
    return jnp.split(proj, offsets, axis=-1)


def _centred_conv(x, w):
    k_w = w.shape[0]
    t = x.shape[1]
    p = k_w // 2
    xp = jnp.pad(x, ((0, 0), (p, p), (0, 0)))
    return sum(xp[:, i:i + t] * w[i] for i in range(k_w))


def _gdn_inputs(qkv, beta_logit, decay_logit, conv_w, a_log, dt_bias):
    B, T, _ = qkv.shape
    qkv = jax.nn.silu(_centred_conv(qkv, conv_w))
    q, k, v = jnp.split(qkv, [GDN_HEADS * GDN_DK, 2 * GDN_HEADS * GDN_DK], axis=-1)
    q = _l2norm(q.reshape(B, T, GDN_HEADS, GDN_DK))
    k = _l2norm(k.reshape(B, T, GDN_HEADS, GDN_DK))
    v = v.reshape(B, T, GDN_HEADS, GDN_DV)
    beta = jax.nn.sigmoid(beta_logit.astype(jnp.float32)).reshape(B, T, 2, GDN_HEADS)
    g = -jnp.exp(a_log.astype(jnp.float32)) * jax.nn.softplus(
        decay_logit.astype(jnp.float32).reshape(B, T, 2, GDN_HEADS) + dt_bias.astype(jnp.float32))
    return q, k, v, g, beta


def _chunk_gated_delta(q, k, v, g, beta, state0):
    in_dtype = v.dtype
    B, T, H, DK = q.shape
    C = GDN_CHUNK
    n = T // C

    def chunks(t):
        return t.astype(jnp.float32).reshape(B, n, C, H, -1).transpose(0, 3, 1, 2, 4)

    q = chunks(q) * (DK ** -0.5)
    k = chunks(k)
    v = chunks(v)
    gc = jnp.cumsum(chunks(g[..., None])[..., 0], axis=-1)
    beta = chunks(beta[..., None])
    tri = jnp.tril(jnp.ones((C, C), dtype=bool))
    strict = jnp.tril(jnp.ones((C, C), dtype=bool), -1)
    diff = gc[..., :, None] - gc[..., None, :]
    decay = jnp.where(tri, jnp.exp(jnp.where(tri, diff, 0.0)), 0.0)
    kb = k * beta
    vb = v * beta
    a_mat = jnp.where(strict, jnp.einsum('bhnid,bhnjd->bhnij', kb, k) * decay, 0.0)
    eye = jnp.eye(C, dtype=jnp.float32)
    t_mat = lax.linalg.triangular_solve(eye + a_mat, jnp.broadcast_to(eye, a_mat.shape),
                                        left_side=True, lower=True, unit_diagonal=True)
    u = jnp.einsum('bhnij,bhnjd->bhnid', t_mat, vb)
    w = jnp.einsum('bhnij,bhnjd->bhnid', t_mat, kb * jnp.exp(gc)[..., None])
    qk = jnp.where(tri, jnp.einsum('bhnid,bhnjd->bhnij', q, k) * decay, 0.0)
    q_dec = q * jnp.exp(gc)[..., None]
    k_dec = k * jnp.exp(gc[..., -1:] - gc)[..., None]
    g_last = jnp.exp(gc[..., -1])
    xs = tuple(jnp.moveaxis(t, 2, 0) for t in (u, w, qk, q_dec, k_dec, g_last))

    def step(s, inp):
        u_i, w_i, qk_i, qd_i, kd_i, gl_i = inp
        v_new = u_i - jnp.einsum('bhcd,bhde->bhce', w_i, s)
        o_i = jnp.einsum('bhcd,bhde->bhce', qd_i, s) + jnp.einsum('bhcj,bhje->bhce', qk_i, v_new)
        s = s * gl_i[..., None, None] + jnp.einsum('bhcd,bhce->bhde', kd_i, v_new)
        return s, o_i

    s_final, o = lax.scan(step, state0.astype(jnp.float32), xs)
    o = jnp.moveaxis(o, 0, 2).transpose(0, 2, 3, 1, 4).reshape(B, T, H, -1)
    return o.astype(in_dtype), s_final


def _bidirectional_gdn(q, k, v, g, beta, s0_fwd, s0_bwd):
    o_f, s_f = _chunk_gated_delta(q, k, v, g[:, :, 0], beta[:, :, 0], s0_fwd)
    rev = lambda t: jnp.flip(t, axis=1)
    o_b, s_b = _chunk_gated_delta(rev(q), rev(k), rev(v), rev(g[:, :, 1]), rev(beta[:, :, 1]), s0_bwd)
    return o_f + rev(o_b), s_f, s_b


def _gdn_out(o, z, w_norm):
    B, T = o.shape[:2]
    y = _rms(o, w_norm) * jax.nn.silu(z.reshape(B, T, GDN_HEADS, GDN_DV))
    return y.reshape(B, T, GDN_HEADS * GDN_DV)


def _axial_rope(x, row, col):
    inv = ROPE_THETA ** (-jnp.arange(ROPE_FREQS, dtype=jnp.float32) / ROPE_FREQS)

    def rotate(seg, pos):
        ang = pos[:, None] * inv
        cos = jnp.cos(ang)[None, :, None, :].astype(seg.dtype)
        sin = jnp.sin(ang)[None, :, None, :].astype(seg.dtype)
        x1, x2 = seg[..., :ROPE_FREQS], seg[..., ROPE_FREQS:]
        return jnp.concatenate([x1 * cos - x2 * sin, x2 * cos + x1 * sin], axis=-1)

    return jnp.concatenate([rotate(x[..., :ROPE_AXIS], row), rotate(x[..., ROPE_AXIS:], col)], axis=-1)


def _mla_qkv(cq, ckv, k_rope, q_a_norm, kv_a_norm, w_uq, w_ukv, q_norm, k_norm, pos):
    B, T, _ = cq.shape
    q = (_rms(cq, q_a_norm) @ w_uq).reshape(B, T, MLA_HEADS, MLA_QK)
    kv = (_rms(ckv, kv_a_norm) @ w_ukv).reshape(B, T, MLA_HEADS, MLA_NOPE + MLA_V)
    k_nope, v = kv[..., :MLA_NOPE], kv[..., MLA_NOPE:]
    k = jnp.concatenate([k_nope, jnp.broadcast_to(k_rope[:, :, None, :], (B, T, MLA_HEADS, MLA_ROPE))], axis=-1)
    q = _rms(q, q_norm)
    k = _rms(k, k_norm)
    if pos is not None:
        row, col = pos
        q = jnp.concatenate([q[..., :MLA_NOPE], _axial_rope(q[..., MLA_NOPE:], row, col)], axis=-1)
        k = jnp.concatenate([k[..., :MLA_NOPE], _axial_rope(k[..., MLA_NOPE:], row, col)], axis=-1)
    return q, k, v


def _softmax_attend(q, k, v):
    s = jnp.einsum('bqhd,bkhd->bhqk', q, k).astype(jnp.float32) * (MLA_QK ** -0.5)
    p = jax.nn.softmax(s, axis=-1).astype(v.dtype)
    return jnp.einsum('bhqk,bkhd->bqhd', p, v)


def _blockwise_attention(q, k, v):
    B, T, H, _ = q.shape
    nb = T // Q_BLOCK
    qb = jnp.moveaxis(q.reshape(B, nb, Q_BLOCK, H, -1), 1, 0)
    o = lax.map(lambda qq: _softmax_attend(qq, k, v), qb)
    return jnp.moveaxis(o, 0, 1).reshape(B, T, H * v.shape[-1])


def _merge(o_gdn, o_mla, gate_logits, w_branch_gdn, w_branch_mla, w_out):
    g_gdn, g_mla = jnp.split(gate_logits, N_BRANCH, axis=-1)
    y = jax.nn.sigmoid(g_gdn) * (o_gdn @ w_branch_gdn) + jax.nn.sigmoid(g_mla) * (o_mla @ w_branch_mla)
    return y @ w_out


def _sq_relu_mlp(h, w1, w2):
    return jnp.square(jax.nn.relu(h @ w1)) @ w2


def setup_inputs(seed: int = 0) -> dict:
    key = jax.random.key(seed)
    ks = jax.random.split(key, 24)
    D = D_MODEL

    def nrm(k, shape, scale):
        return jax.random.normal(k, shape, jnp.float32) * scale

    def gain(k, n):
        return 1.0 + nrm(k, (DEPTH, n), 0.02)

    dt = jnp.exp(jax.random.uniform(ks[9], (DEPTH, 2, GDN_HEADS), jnp.float32,
                                    minval=math.log(DT_MIN), maxval=math.log(DT_MAX)))
    return {
        'x': nrm(ks[0], (BATCH, SEQ, D), 1.0),
        'c': nrm(ks[1], (BATCH, D), 1.0),
        'ctx': nrm(ks[2], (BATCH, CTX_LEN, D), 1.0),
        'c_ctx': nrm(ks[3], (D,), 1.0),
        'w_mod': nrm(ks[4], (DEPTH, D, N_MOD * D), D ** -0.5),
        'b_mod': nrm(ks[5], (DEPTH, N_MOD * D), 0.01),
        'norm_attn': gain(ks[6], D),
        'norm_mlp': gain(ks[7], D),
        'w_in': nrm(ks[8], (DEPTH, D, IN_COLS), D ** -0.5),
        'conv_qkv': nrm(ks[10], (DEPTH, GDN_CONV, GDN_QKV_W), GDN_CONV ** -0.5),
        'gdn_a_log': jnp.log(jax.random.uniform(ks[11], (DEPTH, 2, GDN_HEADS), jnp.float32, minval=1.0, maxval=16.0)),
        'gdn_dt_bias': dt + jnp.log(-jnp.expm1(-dt)),
        'gdn_out_norm': gain(ks[12], GDN_DV),
        'mla_q_a_norm': gain(ks[13], MLA_Q_LORA),
        'mla_kv_a_norm': gain(ks[14], MLA_KV_LORA),
        'w_uq': nrm(ks[15], (DEPTH, MLA_Q_LORA, MLA_HEADS * MLA_QK), MLA_Q_LORA ** -0.5),
        'w_ukv': nrm(ks[16], (DEPTH, MLA_KV_LORA, MLA_HEADS * (MLA_NOPE + MLA_V)), MLA_KV_LORA ** -0.5),
        'q_norm': gain(ks[17], MLA_QK),
        'k_norm': gain(ks[18], MLA_QK),
        'w_branch_gdn': nrm(ks[19], (DEPTH, GDN_HEADS * GDN_DV, D), (GDN_HEADS * GDN_DV) ** -0.5),
        'w_branch_mla': nrm(ks[20], (DEPTH, MLA_HEADS * MLA_V, D), (MLA_HEADS * MLA_V) ** -0.5),
        'w_out': nrm(ks[21], (DEPTH, D, D), D ** -0.5),
        'w_mlp_in': nrm(ks[22], (DEPTH, D, D_FF), D ** -0.5),
        'w_mlp_out': nrm(ks[23], (DEPTH, D_FF, D), 0.5 * D_FF ** -0.5),
    }


def reference(x, c, ctx, c_ctx, w_mod, b_mod, norm_attn, norm_mlp, w_in, conv_qkv, gdn_a_log, gdn_dt_bias,
              gdn_out_norm, mla_q_a_norm, mla_kv_a_norm, w_uq, w_ukv, q_norm, k_norm, w_branch_gdn,
              w_branch_mla, w_out, w_mlp_in, w_mlp_out):
    B, L, _ = x.shape
    lc = ctx.shape[1]
    rows = L // GRID_W
    row = jnp.repeat(jnp.arange(rows, dtype=jnp.float32), GRID_W)
    col = jnp.tile(jnp.arange(GRID_W, dtype=jnp.float32), rows)
    silu_c = jax.nn.silu(c)[:, None, :]
    silu_cc = jax.nn.silu(c_ctx)
    zero_state = jnp.zeros((B, GDN_HEADS, GDN_DK, GDN_DV), jnp.float32)

    for l in range(DEPTH):
        mod_x = jnp.split(silu_c @ w_mod[l] + b_mod[l], N_MOD, axis=-1)
        mod_c = jnp.split(silu_cc @ w_mod[l] + b_mod[l], N_MOD, axis=-1)

        h = _modulate(_rms(x, norm_attn[l]), mod_x[0], mod_x[1])
        hc = _modulate(_rms(ctx, norm_attn[l]), mod_c[0], mod_c[1])
        qkv, z, beta_lg, decay_lg, cq, ckv, k_rope, gates = _split_in(h @ w_in[l])
        qkv_c, z_c, beta_lg_c, decay_lg_c, cq_c, ckv_c, k_rope_c, gates_c = _split_in(hc @ w_in[l])

        qa_c, ka_c, va_c, g_c, beta_c = _gdn_inputs(qkv_c, beta_lg_c, decay_lg_c, conv_qkv[l], gdn_a_log[l], gdn_dt_bias[l])
        o_gdn_c, s_fwd, s_bwd = _bidirectional_gdn(qa_c, ka_c, va_c, g_c, beta_c, zero_state, zero_state)
        qa, ka, va, g, beta = _gdn_inputs(qkv, beta_lg, decay_lg, conv_qkv[l], gdn_a_log[l], gdn_dt_bias[l])
        o_gdn, _, _ = _bidirectional_gdn(qa, ka, va, g, beta, s_fwd, s_bwd)

        qb, kb, vb = _mla_qkv(cq, ckv, k_rope, mla_q_a_norm[l], mla_kv_a_norm[l], w_uq[l], w_ukv[l],
                              q_norm[l], k_norm[l], (row, col))
        qb_c, kb_c, vb_c = _mla_qkv(cq_c, ckv_c, k_rope_c, mla_q_a_norm[l], mla_kv_a_norm[l], w_uq[l], w_ukv[l],
                                    q_norm[l], k_norm[l], None)
        o_mla = _blockwise_attention(qb, jnp.concatenate([kb_c, kb], axis=1), jnp.concatenate([vb_c, vb], axis=1))

        x = x + mod_x[2] * _merge(_gdn_out(o_gdn, z, gdn_out_norm[l]), o_mla, gates,
                                  w_branch_gdn[l], w_branch_mla[l], w_out[l])
        x = x + mod_x[5] * _sq_relu_mlp(_modulate(_rms(x, norm_mlp[l]), mod_x[3], mod_x[4]), w_mlp_in[l], w_mlp_out[l])

        if l < DEPTH - 1:
            o_mla_c = _softmax_attend(qb_c, kb_c, vb_c).reshape(B, lc, MLA_HEADS * MLA_V)
            ctx = ctx + mod_c[2] * _merge(_gdn_out(o_gdn_c, z_c, gdn_out_norm[l]), o_mla_c, gates_c,
                                          w_branch_gdn[l], w_branch_mla[l], w_out[l])
            ctx = ctx + mod_c[5] * _sq_relu_mlp(_modulate(_rms(ctx, norm_mlp[l]), mod_c[3], mod_c[4]),
                                                w_mlp_in[l], w_mlp_out[l])
    return x
```

```cpp
#include <hip/hip_runtime.h>
#include <hip/hip_bf16.h>
#include <hip/hip_cooperative_groups.h>
#include <cstdio>
#include <cstdint>
namespace cg = cooperative_groups;
#ifndef ATT_SDEPTH
#define ATT_SDEPTH 1
#endif
namespace pg8 {
#define PG8_LAS __attribute__((address_space(3)))
typedef unsigned short bf16_t;
typedef short bf16x8 __attribute__((ext_vector_type(8)));
typedef float f32x4 __attribute__((ext_vector_type(4)));
typedef unsigned u32x4 __attribute__((ext_vector_type(4)));
constexpr int BM = 256, BK = 64, HALF = 128, HTB = HALF * BK * 2  , STAGE_BYTES = 8 * HTB, NXCD = 8, WGM = 8;

__host__ __device__ __forceinline__ int lds_byte(int r, int c) { const int st = (r >> 4) * 2 + (c >> 5), rr = r & 15, cc = c & 31, ob = rr * 64 + cc * 2; return st * 1024 + (ob ^ (((ob >> 9) & 1) << 5)); }
__host__ __device__ __forceinline__ void stage_rc(int b, int& R, int& C) { const int st = b / 1024, sb = b % 1024, swz = sb ^ (((sb >> 9) & 1) << 5); R = (st >> 1) * 16 + swz / 64; C = (st & 1) * 32 + (swz % 64) / 2; }
__host__ __device__ __forceinline__ int perm32(int rho) { const int n = rho >> 4, i = rho & 15; return 8 * (i >> 2) + 4 * n + (i & 3); }

struct Unit { int pm, pn; };
struct Gemm { const bf16_t* A; const bf16_t* Bt; int M, N, K; };

struct StaticOrder {
    int nM, nN, nwg, G, c;
    __host__ __device__ void init(int M, int N, int G_, int c_) { nM = M / BM; nN = N / BM; nwg = nM * nN; G = G_; c = c_; }
    __host__ __device__ bool next(int i, Unit& u) const {
        const long L = (long)i * G + c; if (L >= nwg) return false;
        int wgid = (int)L; { const int q = nwg / NXCD, r = nwg % NXCD, xcd = wgid % NXCD, off = wgid / NXCD; wgid = (xcd < r ? xcd * (q + 1) : r * (q + 1) + (xcd - r) * q) + off; }
        const int nig = WGM * nN, gid = wgid / nig, fm = gid * WGM, gsz = (nM - fm) < WGM ? (nM - fm) : WGM;
        u.pm = fm + ((wgid % nig) % gsz); u.pn = (wgid % nig) / gsz; return true;
    }
    __device__ __forceinline__ void a_ready(const Unit&) const {}
    __device__ __forceinline__ void done(const Unit&) const {}
};

__device__ __forceinline__ unsigned cvt_pk_s(float lo, float hi) { typedef float f2 __attribute__((ext_vector_type(2))); typedef __bf16 b2 __attribute__((ext_vector_type(2))); f2 v = {lo, hi}; b2 b = __builtin_convertvector(v, b2); return __builtin_bit_cast(unsigned, b); }
__device__ __forceinline__ u32x4 pack8(f32x4 v0, f32x4 v1) { u32x4 w; w.x = cvt_pk_s(v0[0], v0[1]); w.y = cvt_pk_s(v0[2], v0[3]); w.z = cvt_pk_s(v1[0], v1[1]); w.w = cvt_pk_s(v1[2], v1[3]); return w; }
__device__ __forceinline__ float bflo(unsigned w) { return __builtin_bit_cast(float, w << 16); }
__device__ __forceinline__ float bfhi(unsigned w) { return __builtin_bit_cast(float, w & 0xffff0000u); }
template <class Op> struct EpiOp {
    static constexpr bool PERM = true, AFTER_DRAIN = false;
    Op op;
    __device__ __forceinline__ void operator()(const f32x4 (&acc)[2][2][4][2], const Unit& u, int wr, int wc, int fr, int fq) const {
        const int row0 = u.pm * BM + wr * 64 + fr, col0 = u.pn * BM + wc * 32 + 8 * fq;
#pragma unroll
        for (int ai = 0; ai < 2; ++ai)
#pragma unroll
            for (int m = 0; m < 4; ++m)
#pragma unroll
                for (int bj = 0; bj < 2; ++bj) op(row0 + ai * HALF + m * 16, col0 + bj * HALF, acc[ai][bj][m][0], acc[ai][bj][m][1]);
    }
};
struct OpPlain { static constexpr bool IDEMP = true; bf16_t* O; int ldc;
    __device__ __forceinline__ void operator()(int row, int col, f32x4 v0, f32x4 v1) const { *(u32x4*)(O + (size_t)row * ldc + col) = pack8(v0, v1); } };
struct OpRouteA { static constexpr bool IDEMP = true; bf16_t* cq; bf16_t* ckv; bf16_t* kr; float* bd;
    __device__ __forceinline__ void operator()(int row, int col, f32x4 v0, f32x4 v1) const {
        if (col < 384) *(u32x4*)(cq + (size_t)row * 384 + col) = pack8(v0, v1);
        else if (col < 640) *(u32x4*)(ckv + (size_t)row * 256 + (col - 384)) = pack8(v0, v1);
        else if (col < 704) *(u32x4*)(kr + (size_t)row * 64 + (col - 640)) = pack8(v0, v1);
        else if (col < 736) { float* p = bd + (size_t)row * 32 + (col - 704); *(f32x4*)p = v0; *(f32x4*)(p + 4) = v1; }
    } };
struct OpSplit3 { static constexpr bool IDEMP = true; bf16_t* O; size_t stride; bf16_t* halo;
    __device__ __forceinline__ void operator()(int row, int col, f32x4 v0, f32x4 v1) const { const int t = col >> 10; const u32x4 w = pack8(v0, v1);
        *(u32x4*)(O + (size_t)t * stride + (size_t)row * 1024 + (col & 1023)) = w;
        const int r6 = row & 63;
        if (r6 < 2 || r6 >= 62) { const int slot = r6 < 2 ? r6 : r6 - 60; *(u32x4*)(halo + (((size_t)(row >> 6) * 4 + slot) * 3 + t) * 1024 + (col & 1023)) = w; } } };
struct OpPassA2 { static constexpr bool IDEMP = true; OpRouteA ra; bf16_t* qcx; size_t cst; bf16_t* halo; int row_ctx0;
    __device__ __forceinline__ void operator()(int row, int col, f32x4 v0, f32x4 v1) const {
        if (col >= 6144) { ra(row, col - 6144, v0, v1); return; }
        const int t = col >> 10; const u32x4 w = pack8(v0, v1);
        *(u32x4*)(qcx + (size_t)t * cst + (size_t)(row - row_ctx0) * 1024 + (col & 1023)) = w;
        const int r6 = row & 63;
        if (r6 < 2 || r6 >= 62) { const int slot = r6 < 2 ? r6 : r6 - 60; *(u32x4*)(halo + (((size_t)(row >> 6) * 4 + slot) * 3 + t) * 1024 + (col & 1023)) = w; } } };
struct OpZGate { static constexpr bool IDEMP = true; bf16_t* Z; bf16_t* SG;
    __device__ __forceinline__ void operator()(int row, int col, f32x4 v0, f32x4 v1) const {
        if (col < 1024) { *(u32x4*)(Z + (size_t)row * 1024 + col) = pack8(v0, v1); return; }
#pragma unroll
        for (int i = 0; i < 4; ++i) { v0[i] = __builtin_amdgcn_rcpf(1.f + __expf(-v0[i])); v1[i] = __builtin_amdgcn_rcpf(1.f + __expf(-v1[i])); }
        *(u32x4*)(SG + (size_t)row * 2048 + (col - 1024)) = pack8(v0, v1);
    } };
template <bool ADD> struct OpGate { static constexpr bool IDEMP = !ADD; bf16_t* Y; const bf16_t* SG; int goff;
    __device__ __forceinline__ void operator()(int row, int col, f32x4 v0, f32x4 v1) const {
        const u32x4 g = *(const u32x4*)(SG + (size_t)row * 2048 + goff + col);
        f32x4 a0 = {bflo(g.x), bfhi(g.x), bflo(g.y), bfhi(g.y)}, a1 = {bflo(g.z), bfhi(g.z), bflo(g.w), bfhi(g.w)};
        v0 = v0 * a0; v1 = v1 * a1;
        bf16_t* yp = Y + (size_t)row * 1024 + col;
        if (ADD) { const u32x4 y = *(const u32x4*)yp; f32x4 y0 = {bflo(y.x), bfhi(y.x), bflo(y.y), bfhi(y.y)}, y1 = {bflo(y.z), bfhi(y.z), bflo(y.w), bfhi(y.w)}; v0 = v0 + y0; v1 = v1 + y1; }
        *(u32x4*)yp = pack8(v0, v1);
    } };
struct OpResid { static constexpr bool IDEMP = false; const float* base; float* out; const float* gate;
    __device__ __forceinline__ void operator()(int row, int col, f32x4 v0, f32x4 v1) const {
        const float* gp = gate + (size_t)(row >> 13) * 6144 + col; const size_t off = (size_t)row * 1024 + col;
        const f32x4 g0 = *(const f32x4*)gp, g1 = *(const f32x4*)(gp + 4), b0 = *(const f32x4*)(base + off), b1 = *(const f32x4*)(base + off + 4);
        *(f32x4*)(out + off) = b0 + g0 * v0; *(f32x4*)(out + off + 4) = b1 + g1 * v1;
    } };
struct OpRelu2 { static constexpr bool IDEMP = true; bf16_t* O;
    __device__ __forceinline__ void operator()(int row, int col, f32x4 v0, f32x4 v1) const {
#pragma unroll
        for (int i = 0; i < 4; ++i) { const float a = fmaxf(v0[i], 0.f), b = fmaxf(v1[i], 0.f); v0[i] = a * a; v1[i] = b * b; }
        *(u32x4*)(O + (size_t)row * 4096 + col) = pack8(v0, v1);
    } };
template <class Epi, class Sched, bool ALIGN_EPI = false, bool SP2 = false>
__device__ __forceinline__ void gemm_phase(PG8_LAS unsigned char* lds, const Gemm g, const Sched& S, const Epi& E) {
    int tid_ = threadIdx.x; asm volatile("" : "+v"(tid_));
    const int tid = tid_, wid = __builtin_amdgcn_readfirstlane(tid >> 6), lane = tid & 63, wr = wid >> 2, wc = wid & 3, fr = lane & 15, fq = lane >> 4;
    const int K = g.K, nt = K / BK;
    unsigned voffA[2], voffB[2];
#pragma unroll
    for (int i = 0; i < 2; ++i) { int R, C; stage_rc(tid * 16 + i * 8192, R, C); const int Rb = Epi::PERM ? ((R & ~31) + perm32(R & 31)) : R;
        voffA[i] = (unsigned)(R * K + C) * 2u; voffB[i] = (unsigned)(Rb * K + C) * 2u; }
    const size_t kstep = (size_t)(BK * 2);
    const size_t hstep = (size_t)HALF * K * 2;
    const size_t tstep = 2 * hstep;
    const unsigned ldsw = (unsigned)wid * 1024u;
    const int aoff = lds_byte(wr * 64 + fr, fq * 8), boff = lds_byte(wc * 32 + fr, fq * 8);
#define PG8_SA(b, h) (((b) * 2 + (h)) * HTB)
#define PG8_SB(b, h) ((4 + (b) * 2 + (h)) * HTB)
#define PG8_STAGE(bufoff, gbase, voff) do { _Pragma("unroll") for (int _i = 0; _i < 2; ++_i) \
        __builtin_amdgcn_global_load_lds((const unsigned*)((const char*)(gbase) + (voff)[_i]), (PG8_LAS unsigned*)(lds + (bufoff) + ldsw + _i * 8192), 16, 0, 0); } while (0)
#define PG8_LDA(dst, b, h) do { _Pragma("unroll") for (int m = 0; m < 4; ++m) _Pragma("unroll") for (int k = 0; k < 2; ++k) dst[m][k] = *(const PG8_LAS bf16x8*)(lds + PG8_SA(b, h) + aoff + m * 2048 + k * 1024); } while (0)
#define PG8_LDB(dst, b, h) do { _Pragma("unroll") for (int n = 0; n < 2; ++n) _Pragma("unroll") for (int k = 0; k < 2; ++k) dst[n][k] = *(const PG8_LAS bf16x8*)(lds + PG8_SB(b, h) + boff + n * 2048 + k * 1024); } while (0)
#define PG8_MMA(ai, bj, At, Bt) do { __builtin_amdgcn_s_setprio(1); _Pragma("unroll") for (int m = 0; m < 4; ++m) _Pragma("unroll") for (int n = 0; n < 2; ++n) _Pragma("unroll") for (int k = 0; k < 2; ++k) \
        acc[ai][bj][m][n] = __builtin_amdgcn_mfma_f32_16x16x32_bf16(Bt[n][k], At[m][k], acc[ai][bj][m][n], 0, 0, 0); __builtin_amdgcn_s_setprio(0); } while (0)
#define PG8_WAIT_V(n) asm volatile("s_waitcnt vmcnt(" #n ")" ::: "memory")
#define PG8_WAIT_L(n) asm volatile("s_waitcnt lgkmcnt(" #n ")" ::: "memory")
#define PG8_BAR __builtin_amdgcn_s_barrier()
#define PG8_SCHED __builtin_amdgcn_sched_barrier(0)
    Unit cur, nxt; int ui = 0;
    if (!S.next(0, cur)) return;
    f32x4 acc[2][2][4][2];
#pragma unroll
    for (int a = 0; a < 2; ++a)
#pragma unroll
        for (int b = 0; b < 2; ++b)
#pragma unroll
            for (int m = 0; m < 4; ++m)
#pragma unroll
                for (int n = 0; n < 2; ++n) acc[a][b][m][n] = (f32x4){0.f, 0.f, 0.f, 0.f};
    bf16x8 At[4][2], B0[2][2], B1[2][2];
    const char* cA = (const char*)g.A + (size_t)cur.pm * tstep; const char* cB = (const char*)g.Bt + (size_t)cur.pn * tstep;
    S.a_ready(cur);
    if constexpr (SP2) {
        PG8_STAGE(PG8_SB(0, 0), cB, voffB); PG8_STAGE(PG8_SB(0, 1), cB + hstep, voffB); PG8_STAGE(PG8_SA(0, 0), cA, voffA); PG8_STAGE(PG8_SA(0, 1), cA + hstep, voffA);
        if (wr == 1) PG8_BAR;
        PG8_WAIT_V(2); PG8_BAR;
        PG8_STAGE(PG8_SB(1, 0), cB + kstep, voffB); PG8_STAGE(PG8_SA(1, 0), cA + kstep, voffA); PG8_STAGE(PG8_SB(1, 1), cB + hstep + kstep, voffB);
        PG8_WAIT_V(6); PG8_BAR;
    } else {
        PG8_STAGE(PG8_SB(0, 0), cB, voffB); PG8_STAGE(PG8_SA(0, 0), cA, voffA); PG8_STAGE(PG8_SB(0, 1), cB + hstep, voffB); PG8_STAGE(PG8_SA(0, 1), cA + hstep, voffA);
        if (wr == 1) PG8_BAR;
        PG8_WAIT_V(4); PG8_BAR;
        PG8_STAGE(PG8_SB(1, 0), cB + kstep, voffB); PG8_STAGE(PG8_SA(1, 0), cA + kstep, voffA); PG8_STAGE(PG8_SB(1, 1), cB + hstep + kstep, voffB);
        PG8_WAIT_V(6); PG8_BAR;
    }
    for (;;) {
        const bool has_next = S.next(ui + 1, nxt);
        const char* nA = has_next ? (const char*)g.A + (size_t)nxt.pm * tstep : cA; const char* nB = has_next ? (const char*)g.Bt + (size_t)nxt.pn * tstep : cB;
        for (int t = 0; t < nt; t += 2) {
            const bool last = (t == nt - 2);
            const char* a1 = cA + (size_t)(t + 1) * kstep;
            const char* a2 = last ? nA : cA + (size_t)(t + 2) * kstep; const char* b2 = last ? nB : cB + (size_t)(t + 2) * kstep;
            const char* a3 = a2 + kstep; const char* b3 = b2 + kstep;
            if (last && has_next) S.a_ready(nxt);
            if constexpr (SP2) {
            PG8_LDB(B0, 0, 0); PG8_LDB(B1, 0, 1); PG8_SCHED; PG8_LDA(At, 0, 0); PG8_STAGE(PG8_SA(1, 1), a1 + hstep, voffA);
            PG8_WAIT_V(8); PG8_WAIT_L(0); PG8_BAR; PG8_MMA(0, 0, At, B0); PG8_MMA(0, 1, At, B1); PG8_BAR; PG8_SCHED;
            PG8_LDA(At, 0, 1); PG8_STAGE(PG8_SB(0, 0), b2, voffB); PG8_STAGE(PG8_SB(0, 1), b2 + hstep, voffB); PG8_STAGE(PG8_SA(0, 0), a2, voffA);
            PG8_WAIT_V(8); PG8_WAIT_L(0); PG8_BAR; PG8_MMA(1, 0, At, B0); PG8_MMA(1, 1, At, B1); PG8_BAR; PG8_SCHED;
            PG8_LDB(B0, 1, 0); PG8_LDB(B1, 1, 1); PG8_SCHED; PG8_LDA(At, 1, 0); PG8_STAGE(PG8_SA(0, 1), a2 + hstep, voffA);
            PG8_WAIT_V(8); PG8_WAIT_L(0); PG8_BAR; PG8_MMA(0, 0, At, B0); PG8_MMA(0, 1, At, B1); PG8_BAR; PG8_SCHED;
            PG8_LDA(At, 1, 1); PG8_STAGE(PG8_SB(1, 0), b3, voffB); PG8_STAGE(PG8_SB(1, 1), b3 + hstep, voffB); PG8_STAGE(PG8_SA(1, 0), a3, voffA);
            PG8_WAIT_V(8); PG8_WAIT_L(0); PG8_BAR; PG8_MMA(1, 0, At, B0); PG8_MMA(1, 1, At, B1); PG8_BAR; PG8_SCHED;
            } else {
            PG8_LDB(B0, 0, 0); PG8_SCHED; PG8_LDA(At, 0, 0); PG8_STAGE(PG8_SA(1, 1), a1 + hstep, voffA);
            PG8_WAIT_L(8); PG8_BAR; PG8_WAIT_L(0); PG8_MMA(0, 0, At, B0); PG8_BAR; PG8_SCHED;
            PG8_LDB(B1, 0, 1); PG8_STAGE(PG8_SB(0, 0), b2, voffB);
            PG8_BAR; PG8_WAIT_L(0); PG8_MMA(0, 1, At, B1); PG8_BAR;
            PG8_LDA(At, 0, 1); PG8_STAGE(PG8_SA(0, 0), a2, voffA);
            PG8_BAR; PG8_WAIT_L(0); PG8_MMA(1, 0, At, B0); PG8_BAR; PG8_SCHED;
            PG8_STAGE(PG8_SB(0, 1), b2 + hstep, voffB);
            PG8_WAIT_V(6); PG8_BAR; PG8_MMA(1, 1, At, B1); PG8_BAR;
            PG8_LDB(B0, 1, 0); PG8_SCHED; PG8_LDA(At, 1, 0); PG8_STAGE(PG8_SA(0, 1), a2 + hstep, voffA);
            PG8_WAIT_L(8); PG8_BAR; PG8_WAIT_L(0); PG8_MMA(0, 0, At, B0); PG8_BAR; PG8_SCHED;
            PG8_LDB(B1, 1, 1); PG8_STAGE(PG8_SB(1, 0), b3, voffB);
            PG8_BAR; PG8_WAIT_L(0); PG8_MMA(0, 1, At, B1); PG8_BAR;
            PG8_LDA(At, 1, 1); PG8_STAGE(PG8_SA(1, 0), a3, voffA);
            PG8_BAR; PG8_WAIT_L(0); PG8_MMA(1, 0, At, B0); PG8_BAR; PG8_SCHED;
            PG8_STAGE(PG8_SB(1, 1), b3 + hstep, voffB);
            PG8_WAIT_V(6); PG8_BAR; PG8_MMA(1, 1, At, B1); PG8_BAR;
            }
        }
        if constexpr (ALIGN_EPI) { if (wr == 0) PG8_BAR; }
        if constexpr (!Epi::AFTER_DRAIN) { E(acc, cur, wr, wc, fr, fq); S.done(cur); }
        if (!has_next) break;
#pragma unroll
        for (int a = 0; a < 2; ++a)
#pragma unroll
            for (int b = 0; b < 2; ++b)
#pragma unroll
                for (int m = 0; m < 4; ++m)
#pragma unroll
                    for (int n = 0; n < 2; ++n) acc[a][b][m][n] = (f32x4){0.f, 0.f, 0.f, 0.f};
        cur = nxt; cA = nA; cB = nB; ++ui;
        if constexpr (ALIGN_EPI) { if (wr == 1) PG8_BAR; }
    }
    PG8_WAIT_V(0);
    if constexpr (!ALIGN_EPI) { if (wr == 0) PG8_BAR; }
    PG8_BAR;
    if constexpr (Epi::AFTER_DRAIN) { E.fused(acc, cur, wr, wc, fr, fq, lds, wid, lane); S.done(cur); }
#undef PG8_SA
#undef PG8_SB
#undef PG8_STAGE
#undef PG8_LDA
#undef PG8_LDB
#undef PG8_MMA
#undef PG8_WAIT_V
#undef PG8_WAIT_L
#undef PG8_BAR
#undef PG8_SCHED
}
}
namespace att {
using bf16 = __hip_bfloat16;
constexpr int DQK = 192, DV = 128, NW = 8, QBLK = 32, KVBLK = 64;
constexpr float SCALE = 0.07216878364870323f;
constexpr float THR = 8.f;
constexpr int LDQ = 1536, LDK = 1536, LDV = 2048, LDO = 1024;
#ifndef QKT_GRP
#define QKT_GRP 4
#endif
#ifndef ATT_NQREG
#define ATT_NQREG 12
#endif
constexpr int NQREG = ATT_NQREG;
constexpr int SHM_V = KVBLK * DV * 2, SHM_K = KVBLK * 400, SHM_QL = 2 * SHM_V + 2 * SHM_K + NW * 64 * 4, SHM_ATTN = SHM_QL + NW * (12 - NQREG) * 1024;
using bf16x8 = __attribute__((ext_vector_type(8))) short;
using s16x4  = __attribute__((ext_vector_type(4))) short;
using f32x16 = __attribute__((ext_vector_type(16))) float;
using u32x4  = __attribute__((ext_vector_type(4))) unsigned;
#define KSWZ(row, colB) ((row) * 400 + (colB))
#define SBAR() __builtin_amdgcn_sched_barrier(0)
__device__ __forceinline__ int crow(int r, int hi) { return (r & 3) + 8 * (r >> 2) + 4 * hi; }
__device__ __forceinline__ unsigned cvtpk(float lo, float hi) { unsigned r; asm volatile("v_cvt_pk_bf16_f32 %0, %1, %2" : "=v"(r) : "v"(lo), "v"(hi)); return r; }
__device__ __forceinline__ void partialSM(f32x16& p0, f32x16& p1, float& m_reg, float& mn, float& alpha) {
  constexpr float C = SCALE * 1.4426950408889634f;
  float pmax = p0[0]; for (int r = 1; r < 16; ++r) pmax = fmaxf(pmax, p0[r]); for (int r = 0; r < 16; ++r) pmax = fmaxf(pmax, p1[r]);
  { auto rr = __builtin_amdgcn_permlane32_swap(__float_as_uint(pmax), __float_as_uint(pmax), false, false);
    pmax = fmaxf(__uint_as_float(rr[0]), __uint_as_float(rr[1])); }
  if (__builtin_expect(__all(pmax - m_reg <= THR / SCALE), 1)) { mn = m_reg; alpha = 1.f; }
  else { mn = fmaxf(m_reg, pmax); alpha = __builtin_amdgcn_exp2f((m_reg - mn) * C); m_reg = mn; }
  float mnC = -mn * C;
  for (int r = 0; r < 16; ++r) p0[r] = fmaf(p0[r], C, mnC); for (int r = 0; r < 16; ++r) p1[r] = fmaf(p1[r], C, mnC);
  for (int r = 0; r < 16; ++r) p0[r] = __builtin_amdgcn_exp2f(p0[r]);
}
__device__ __forceinline__ void finishSM(f32x16& p0, f32x16& p1, float alpha, float& l_reg, bf16x8& pa0, bf16x8& pa1, bf16x8& pa2, bf16x8& pa3) {
  for (int r = 0; r < 16; ++r) p1[r] = __builtin_amdgcn_exp2f(p1[r]);
  float ps = 0; for (int r = 0; r < 16; ++r) ps += p0[r]; for (int r = 0; r < 16; ++r) ps += p1[r];
  { auto rr = __builtin_amdgcn_permlane32_swap(__float_as_uint(ps), __float_as_uint(ps), false, false);
    ps = __uint_as_float(rr[0]) + __uint_as_float(rr[1]); }
  l_reg = l_reg * alpha + ps;
#define PK4(P, BASE, OUT) do { unsigned a0 = cvtpk(P[BASE + 0], P[BASE + 1]), a1 = cvtpk(P[BASE + 2], P[BASE + 3]);   \
    unsigned b0 = cvtpk(P[BASE + 4], P[BASE + 5]), b1 = cvtpk(P[BASE + 6], P[BASE + 7]);                              \
    auto r0 = __builtin_amdgcn_permlane32_swap(a0, b0, false, false); auto r1 = __builtin_amdgcn_permlane32_swap(a1, b1, false, false); \
    u32x4 w = {r0[0], r1[0], r0[1], r1[1]}; OUT = *reinterpret_cast<bf16x8*>(&w); } while (0)
  PK4(p0, 0, pa0); PK4(p0, 8, pa1); PK4(p1, 0, pa2); PK4(p1, 8, pa3);
#undef PK4
}
__device__ __forceinline__ void qkt(f32x16& p0, f32x16& p1, const bf16* Ks, const bf16x8* qr, const bf16x8* qL, int r32, int hi) {
  p0 = f32x16{}; p1 = f32x16{};
#pragma unroll
  for (int d0 = 0; d0 < 12; ++d0) { int cb = (d0 * 16 + hi * 8) * 2;
    bf16x8 b0 = *reinterpret_cast<const bf16x8*>((const char*)Ks + KSWZ(r32, cb));
    bf16x8 b1 = *reinterpret_cast<const bf16x8*>((const char*)Ks + KSWZ(32 + r32, cb));
    const bf16x8 qf = (d0 < NQREG) ? qr[d0 < NQREG ? d0 : 0] : qL[(d0 - NQREG) * 64];
    p0 = __builtin_amdgcn_mfma_f32_32x32x16_bf16(b0, qf, p0, 0, 0, 0);
    p1 = __builtin_amdgcn_mfma_f32_32x32x16_bf16(b1, qf, p1, 0, 0, 0);
    if ((d0 & (QKT_GRP - 1)) == QKT_GRP - 1 && d0 != 11) SBAR(); }
}
__device__ __forceinline__ int v_st(int k, int c) { const int kk = (k & ~0xC) | ((k & 4) << 1) | ((k & 8) >> 1); return ((kk >> 3) * 4 + (c >> 5)) * 512 + ((kk & 7) * 32 + (c & 31)) * 2; }
__device__ __forceinline__ int v_rd_base(int lane) { return ((lane & 3) << 3) | (((lane >> 2) & 3) << 6) | (((lane >> 4) & 1) << 5) | (((lane >> 5) & 1) << 8); }
constexpr int v_rd_off(int d0, int ks, int half) { return d0 * 512 + ks * 4096 + half * 2048; }
template <int OFF> __device__ __forceinline__ s16x4 tr_read(int vb) {
  s16x4 r; asm volatile("ds_read_b64_tr_b16 %0, %1 offset:%2" : "=&v"(r) : "v"(vb), "i"(OFF) : "memory"); return r;
}
template <int D0> __device__ __forceinline__ void pv_one(f32x16& od, int vb, bf16x8 pa0, bf16x8 pa1, bf16x8 pa2, bf16x8 pa3) {
  const s16x4 l0 = tr_read<v_rd_off(D0, 0, 0)>(vb), h0 = tr_read<v_rd_off(D0, 0, 1)>(vb), l1 = tr_read<v_rd_off(D0, 1, 0)>(vb), h1 = tr_read<v_rd_off(D0, 1, 1)>(vb);
  const s16x4 l2 = tr_read<v_rd_off(D0, 2, 0)>(vb), h2 = tr_read<v_rd_off(D0, 2, 1)>(vb), l3 = tr_read<v_rd_off(D0, 3, 0)>(vb), h3 = tr_read<v_rd_off(D0, 3, 1)>(vb);
  asm volatile("s_waitcnt lgkmcnt(0)" ::: "memory"); SBAR();
#define PK(L, H) (bf16x8){L[0], L[1], L[2], L[3], H[0], H[1], H[2], H[3]}
  od = __builtin_amdgcn_mfma_f32_32x32x16_bf16(pa0, PK(l0, h0), od, 0, 0, 0);
  od = __builtin_amdgcn_mfma_f32_32x32x16_bf16(pa1, PK(l1, h1), od, 0, 0, 0);
  od = __builtin_amdgcn_mfma_f32_32x32x16_bf16(pa2, PK(l2, h2), od, 0, 0, 0);
  od = __builtin_amdgcn_mfma_f32_32x32x16_bf16(pa3, PK(l3, h3), od, 0, 0, 0);
#undef PK
}
__device__ __forceinline__ void pv_d0(f32x16* o, int vb, bf16x8 pa0, bf16x8 pa1, bf16x8 pa2, bf16x8 pa3) {
  pv_one<0>(o[0], vb, pa0, pa1, pa2, pa3); pv_one<1>(o[1], vb, pa0, pa1, pa2, pa3); pv_one<2>(o[2], vb, pa0, pa1, pa2, pa3); pv_one<3>(o[3], vb, pa0, pa1, pa2, pa3);
}
template <int SDEPTH>
__device__ __forceinline__ void attn_dense_body(const bf16* __restrict__ Qb, const bf16* __restrict__ Kc, const bf16* __restrict__ Kl, const bf16* __restrict__ Vc, const bf16* __restrict__ Vl,
                                                bf16* __restrict__ Ob, int seq, char* lds) {
  const int tid = threadIdx.x, wid = tid >> 6, lane = tid & 63, r32 = lane & 31, hi = lane >> 5;
  bf16* V_lds = (bf16*)lds; bf16* K_lds = (bf16*)(lds + 2 * SHM_V);
  float* ws = (float*)(lds + 2 * SHM_V + 2 * SHM_K) + wid * 64; float* li_l = ws; float* al_l = ws + 32;
  float m_reg = -1e30f, l_reg = 0; f32x16 o[4] = {}; bf16x8 qr[NQREG];
  bf16x8* qL = (bf16x8*)(lds + SHM_QL) + wid * (12 - NQREG) * 64 + lane;
  const bf16* Qw = Qb + (long)(wid * QBLK + r32) * LDQ + hi * 8;
#pragma unroll
  for (int d0 = 0; d0 < 12; ++d0) { const bf16x8 qv = *reinterpret_cast<const bf16x8*>(Qw + d0 * 16); if (d0 < NQREG) qr[d0 < NQREG ? d0 : 0] = qv; else qL[(d0 - NQREG) * 64] = qv; }
  const int sr = tid >> 4, sc = (tid & 15) * 8, vst0 = v_st(sr, sc), vst1 = v_st(32 + sr, sc);
  const int kr0 = tid / 24, kc0 = (tid % 24) * 8, kr1 = (tid + 512) / 24, kc1 = ((tid + 512) % 24) * 8, kr2 = (tid + 1024) / 24, kc2 = ((tid + 1024) % 24) * 8;
  const int kw0 = KSWZ(kr0, kc0 * 2), kw1 = KSWZ(kr1, kc1 * 2), kw2 = KSWZ(kr2, kc2 * 2);
  const int vb0 = (int)(uintptr_t)V_lds + v_rd_base(lane);
  struct { bf16x8 vs0, vs1, ks0, ks1, ks2; } sr_[SDEPTH];
#define KP(k0) ((k0) < 256 ? Kc + (long)(k0) * LDK : Kl + (long)((k0) - 256) * LDK)
#define VP(k0) ((k0) < 256 ? Vc + (long)(k0) * LDV : Vl + (long)((k0) - 256) * LDV)
#define SLOAD(i, k0) do { const bf16* kp_ = KP(k0); const bf16* vp_ = VP(k0); \
    sr_[i].vs0 = *reinterpret_cast<const bf16x8*>(&vp_[(long)sr * LDV + sc]); sr_[i].vs1 = *reinterpret_cast<const bf16x8*>(&vp_[(long)(32 + sr) * LDV + sc]); \
    sr_[i].ks0 = *reinterpret_cast<const bf16x8*>(&kp_[(long)kr0 * LDK + kc0]); sr_[i].ks1 = *reinterpret_cast<const bf16x8*>(&kp_[(long)kr1 * LDK + kc1]); \
    sr_[i].ks2 = *reinterpret_cast<const bf16x8*>(&kp_[(long)kr2 * LDK + kc2]); } while (0)
#define SWRITE(b, i) do { *(bf16x8*)((char*)V_lds + (b) * SHM_V + vst0) = sr_[i].vs0; *(bf16x8*)((char*)V_lds + (b) * SHM_V + vst1) = sr_[i].vs1; \
    *(bf16x8*)((char*)K_lds + (b) * SHM_K + kw0) = sr_[i].ks0; *(bf16x8*)((char*)K_lds + (b) * SHM_K + kw1) = sr_[i].ks1; *(bf16x8*)((char*)K_lds + (b) * SHM_K + kw2) = sr_[i].ks2; } while (0)
#define SWAIT() do { if constexpr (SDEPTH == 2) asm volatile("s_waitcnt vmcnt(5)" ::: "memory"); else asm volatile("s_waitcnt vmcnt(0)" ::: "memory"); } while (0)
#define RESC(a) do { if (__any((a) < 1.f)) { if (hi == 0) al_l[r32] = (a); asm volatile("s_waitcnt lgkmcnt(0)" ::: "memory"); \
    for (int d = 0; d < 4; ++d) for (int r = 0; r < 16; ++r) o[d][r] *= al_l[crow(r, hi)]; } } while (0)
  f32x16 pA0, pA1, pB0, pB1; float mnA, mnB, alA, alB; bf16x8 pa0, pa1, pa2, pa3; const int NT = seq / KVBLK;
  constexpr int SE = 0, SO = SDEPTH - 1;
  SLOAD(SE, 0); asm volatile("s_waitcnt vmcnt(0)" ::: "memory"); SWRITE(0, SE); __syncthreads();
  qkt(pA0, pA1, K_lds, qr, qL, r32, hi); partialSM(pA0, pA1, m_reg, mnA, alA);
  SLOAD(SO, KVBLK); if constexpr (SDEPTH == 2) { if (2 < NT) SLOAD(SE, 2 * KVBLK); }
  SWAIT(); SWRITE(1, SO); __syncthreads();
  for (int j = 1; j + 1 < NT; j += 2) {
    SBAR(); qkt(pB0, pB1, (bf16*)((char*)K_lds + SHM_K), qr, qL, r32, hi);
    finishSM(pA0, pA1, alA, l_reg, pa0, pa1, pa2, pa3); SBAR();
    SLOAD(SO, (j + SDEPTH) * KVBLK); SBAR();
    pv_d0(o, vb0, pa0, pa1, pa2, pa3); partialSM(pB0, pB1, m_reg, mnB, alB);
    __syncthreads(); SWAIT(); SWRITE(0, SE);
    RESC(alB); __syncthreads();
    SBAR(); qkt(pA0, pA1, K_lds, qr, qL, r32, hi);
    finishSM(pB0, pB1, alB, l_reg, pa0, pa1, pa2, pa3); SBAR();
    if (SDEPTH == 1 || j + 3 < NT) SLOAD(SE, (j + 1 + SDEPTH) * KVBLK); SBAR();
    pv_d0(o, vb0 + (int)SHM_V, pa0, pa1, pa2, pa3); partialSM(pA0, pA1, m_reg, mnA, alA);
    __syncthreads(); SWAIT(); SWRITE(1, SO);
    RESC(alA); __syncthreads();
  }
  SBAR(); qkt(pB0, pB1, (bf16*)((char*)K_lds + SHM_K), qr, qL, r32, hi);
  finishSM(pA0, pA1, alA, l_reg, pa0, pa1, pa2, pa3); SBAR();
  pv_d0(o, vb0, pa0, pa1, pa2, pa3); partialSM(pB0, pB1, m_reg, mnB, alB);
  __syncthreads(); RESC(alB);
  finishSM(pB0, pB1, alB, l_reg, pa0, pa1, pa2, pa3); SBAR();
  pv_d0(o, vb0 + (int)SHM_V, pa0, pa1, pa2, pa3);
  if (hi == 0) li_l[r32] = l_reg; asm volatile("s_waitcnt lgkmcnt(0)" ::: "memory");
  float rli[16];
#pragma unroll
  for (int r = 0; r < 16; ++r) rli[r] = __builtin_amdgcn_rcpf(li_l[crow(r, hi)]);
  bf16* Ow = Ob + (long)(wid * QBLK) * LDO;
#pragma unroll
  for (int r = 0; r < 16; ++r) { int orow = crow(r, hi);
#pragma unroll
    for (int d0 = 0; d0 < 4; ++d0) Ow[(long)orow * LDO + d0 * 32 + r32] = __float2bfloat16(o[d0][r] * rli[r]); }
  __syncthreads();
#undef KP
#undef VP
#undef SLOAD
#undef SWRITE
#undef SWAIT
#undef RESC
}
#undef KSWZ
#undef SBAR
}
constexpr int DM = 1024, NBAT = 4, SEQ = 8192, CTXL = 256, ML = NBAT * SEQ, MC = NBAT * CTXL, MT = ML + MC;
constexpr int INC = 6880, NMODC = 6144;
constexpr float EPS = 1e-6f;
constexpr int NWAVES = 8, NTHR = 512;
constexpr size_t MiB = 1u << 20;
constexpr size_t WS_CTL = 0, CTL_ZERO_BYTES = 65536; constexpr int CW_BAR = 1024;
constexpr size_t WS_ROPE = 1 * MiB + 512 * 1024;
constexpr size_t WS_MOD = 1 * MiB, WS_WIN = 2 * MiB, WS_WUQ = 16 * MiB, WS_WUKV = 18 * MiB, WS_WBG = 20 * MiB, WS_WBM = 22 * MiB, WS_WOUT = 24 * MiB, WS_WM1 = 26 * MiB, WS_WM2 = 34 * MiB;
constexpr size_t WS_BD = 42 * MiB, WS_GCU = 47 * MiB, WS_BTU = 50 * MiB, WS_HALO = 53 * MiB, WS_TCTX = 66 * MiB, WS_H = 68 * MiB;
constexpr size_t WS_CQ = 134 * MiB, WS_CKV = 159 * MiB, WS_KR = 176 * MiB, WS_KVRAW = 181 * MiB, WS_KF = 313 * MiB, WS_O = 448 * MiB;
constexpr size_t WS_QR = 134 * MiB, QKV_STRIDE = (size_t)MT * 1024  , WS_OF = 332 * MiB;
constexpr size_t WS_Z = 134 * MiB, WS_SG = 200 * MiB, WS_Y = 134 * MiB, WS_HID = 134 * MiB, WS_END = 512 * MiB;
constexpr int LDS_BYTES = 163840;

#define LAS __attribute__((address_space(3)))
typedef unsigned short bf16_t;
typedef short bf16x8 __attribute__((ext_vector_type(8)));
typedef float f32x4 __attribute__((ext_vector_type(4)));
typedef float f32x16 __attribute__((ext_vector_type(16)));
typedef unsigned u32x4 __attribute__((ext_vector_type(4)));
typedef unsigned u32x2 __attribute__((ext_vector_type(2)));
#define LDS_WAIT() asm volatile("s_waitcnt lgkmcnt(0)" ::: "memory")
__device__ __forceinline__ unsigned pk2(float lo, float hi) { return pg8::cvt_pk_s(lo, hi); }
__device__ __forceinline__ float bflo(unsigned w) { return __builtin_bit_cast(float, w << 16); }
__device__ __forceinline__ float bfhi(unsigned w) { return __builtin_bit_cast(float, w & 0xffff0000u); }
__device__ __forceinline__ float bf1(bf16_t h) { return __builtin_bit_cast(float, (unsigned)h << 16); }
__device__ __forceinline__ bf16_t f2bf(float f) { return (bf16_t)(pk2(f, 0.f) & 0xffffu); }
__device__ __forceinline__ void unpack8(u32x4 w, float* f) { f[0] = bflo(w.x); f[1] = bfhi(w.x); f[2] = bflo(w.y); f[3] = bfhi(w.y); f[4] = bflo(w.z); f[5] = bfhi(w.z); f[6] = bflo(w.w); f[7] = bfhi(w.w); }
__device__ __forceinline__ u32x4 pack8f(const float* f) { u32x4 w; w.x = pk2(f[0], f[1]); w.y = pk2(f[2], f[3]); w.z = pk2(f[4], f[5]); w.w = pk2(f[6], f[7]); return w; }
__device__ __forceinline__ float wave_sum(float v) {
#pragma unroll
    for (int o = 1; o < 64; o <<= 1) v += __shfl_xor(v, o);
    return v;
}
__device__ __forceinline__ float siluf(float x) { return x * __builtin_amdgcn_rcpf(1.f + __expf(-x)); }
__device__ __forceinline__ float rsqf(float x) { return __builtin_amdgcn_rsqf(x); }
__device__ __forceinline__ int crow(int r, int hi) { return (r & 3) + 8 * (r >> 2) + 4 * hi; }
#define MFMA32(a, b, c) __builtin_amdgcn_mfma_f32_32x32x16_bf16((a), (b), (c), 0, 0, 0)

struct Args { const float* in[24]; float* out; unsigned char* ws; int ph_lo, ph_hi; };

__device__ __forceinline__ void transpose_item(const float* W, int ldw, int col0, int K, bf16_t* WT, int row0, int nblk, LAS float* scr, int item, int lane) {
    const int kb = item / nblk, nb = item % nblk, k0 = 64 * kb, n0 = 32 * nb;
    float tw_[32];
#pragma unroll
    for (int i = 0; i < 32; ++i) { const int kk = 2 * i + (lane >> 5); tw_[i] = W[(size_t)(k0 + kk) * ldw + col0 + n0 + (lane & 31)]; }
#pragma unroll
    for (int i = 0; i < 32; ++i) { const int kk = 2 * i + (lane >> 5); scr[kk * 33 + (lane & 31)] = tw_[i]; }
    LDS_WAIT(); asm volatile("" ::: "memory");
    const int c = lane & 7;
#pragma unroll
    for (int j = 0; j < 4; ++j) { const int n = (lane >> 3) + 8 * j; const LAS float* s = scr + (8 * c) * 33 + n;
        u32x4 o; o.x = pk2(s[0 * 33], s[1 * 33]); o.y = pk2(s[2 * 33], s[3 * 33]); o.z = pk2(s[4 * 33], s[5 * 33]); o.w = pk2(s[6 * 33], s[7 * 33]);
        *(u32x4*)(WT + (size_t)(row0 + n0 + n) * K + k0 + 8 * c) = o; }
    LDS_WAIT(); asm volatile("" ::: "memory");
}
__device__ __forceinline__ void p0_prologue(const Args& a, LAS unsigned char* lds, int tid, int lane, int wave) {
    unsigned char* ws = a.ws;
    LAS float* scr = (LAS float*)(lds + wave * 16384);
    const int gw = blockIdx.x * NWAVES + wave, NGW = gridDim.x * NWAVES;
    bf16_t* WIN = (bf16_t*)(ws + WS_WIN);
    int total = 0;
#define REGION_COUNT(inidx, ldw, col0, nc, K, dst, row0) total += ((K) / 64) * ((nc) / 32);
#define REGION_RUN(inidx, ldw, col0, nc, K, dst, row0) { const int n_ = ((K) / 64) * ((nc) / 32); \
        if (rem >= 0 && rem < n_) transpose_item(a.in[inidx], ldw, col0, K, (bf16_t*)(ws + (dst)), row0, (nc) / 32, scr, rem, lane); rem -= n_; }
#define REGIONS(X) X(8, INC, 0, 4096, 1024, WS_WIN, 0) X(8, INC, 4832, 2048, 1024, WS_WIN, 4096) X(8, INC, 4128, 704, 1024, WS_WIN, 6144) X(8, INC, 4096, 32, 1024, WS_WIN, 6848) \
        X(15, 1536, 0, 1536, 384, WS_WUQ, 0) X(16, 2048, 0, 2048, 256, WS_WUKV, 0) X(19, 1024, 0, 1024, 1024, WS_WBG, 0) X(20, 1024, 0, 1024, 1024, WS_WBM, 0) \
        X(21, 1024, 0, 1024, 1024, WS_WOUT, 0) X(22, 4096, 0, 4096, 1024, WS_WM1, 0) X(23, 1024, 0, 1024, 4096, WS_WM2, 0)
    REGIONS(REGION_COUNT)
    for (int it = gw; it < total; it += NGW) { int rem = it; REGIONS(REGION_RUN) }
#undef REGIONS
#undef REGION_RUN
#undef REGION_COUNT
    for (int i = blockIdx.x * NTHR + tid; i < 32 * 1024 / 8; i += gridDim.x * NTHR) *(u32x4*)(WIN + (size_t)6880 * 1024 + (size_t)i * 8) = (u32x4){0u, 0u, 0u, 0u};
    if (blockIdx.x == gridDim.x - 1) { float* tab = (float*)(ws + WS_ROPE);
        for (int i = tid; i < 2048; i += NTHR) { const float inv = exp2f(-(float)(i & 15) * (13.287712379549449f / 16.f)); const float ang = (float)(i >> 4) * inv; tab[i] = cosf(ang); tab[2048 + i] = sinf(ang); } }
    __syncthreads();
    LAS float* sc = (LAS float*)lds;
    LAS float* red = (LAS float*)(lds + 20480);
    if ((int)blockIdx.x < NMODC / 32) {
        for (int i = tid; i < 5 * 1024; i += NTHR) { const float v = (i < 4096) ? a.in[1][i] : a.in[3][i - 4096]; sc[i] = siluf(v); }
        __syncthreads();
        const float* wm = a.in[4]; const float* bm = a.in[5]; float* mod = (float*)(ws + WS_MOD);
        for (int cb = blockIdx.x; cb < NMODC / 32; cb += gridDim.x) {
            const int cq4 = tid & 7, kg = tid >> 3, n = cb * 32 + cq4 * 4;
            f32x4 wv[16];
#pragma unroll
            for (int it = 0; it < 16; ++it) wv[it] = *(const f32x4*)(wm + (size_t)(kg + 64 * it) * NMODC + n);
            f32x4 acc[5];
#pragma unroll
            for (int r = 0; r < 5; ++r) acc[r] = (f32x4){0.f, 0.f, 0.f, 0.f};
#pragma unroll
            for (int it = 0; it < 16; ++it) {
#pragma unroll
                for (int r = 0; r < 5; ++r) acc[r] += wv[it] * sc[r * 1024 + kg + 64 * it]; }
#pragma unroll
            for (int r = 0; r < 5; ++r) *(LAS f32x4*)(red + (kg * 5 + r) * 32 + cq4 * 4) = acc[r];
            __syncthreads();
            if (tid < 160) { const int r = tid >> 5, c2 = tid & 31; float s = 0.f;
                for (int g = 0; g < 64; ++g) s += red[(g * 5 + r) * 32 + c2];
                mod[(size_t)r * NMODC + cb * 32 + c2] = s + bm[cb * 32 + c2]; }
            __syncthreads();
        }
    }
}
__device__ __forceinline__ void rms_mod_rows(const float* xl, const float* xc, int nrows, const float* nw, const float* mod, int shift_i, int scale_i, bf16_t* out, int lane, int wave) {
    const int gw = blockIdx.x * NWAVES + wave, NGW = gridDim.x * NWAVES;
    if (gw >= nrows) return;
    f32x4 wv[4];
#pragma unroll
    for (int j = 0; j < 4; ++j) wv[j] = *(const f32x4*)(nw + 4 * lane + 256 * j);
    f32x4 vn[4];
    { const float* xr = (gw < ML) ? xl + (size_t)gw * DM : xc + (size_t)(gw - ML) * DM;
#pragma unroll
      for (int j = 0; j < 4; ++j) vn[j] = *(const f32x4*)(xr + 4 * lane + 256 * j); }
#pragma unroll 1
    for (int m = gw; m < nrows; m += NGW) {
        f32x4 v[4];
#pragma unroll
        for (int j = 0; j < 4; ++j) v[j] = vn[j];
        { const int mn = (m + NGW < nrows) ? m + NGW : m; const float* xr = (mn < ML) ? xl + (size_t)mn * DM : xc + (size_t)(mn - ML) * DM;
#pragma unroll
          for (int j = 0; j < 4; ++j) vn[j] = *(const f32x4*)(xr + 4 * lane + 256 * j); }
        const float* mr = mod + (size_t)((m < ML) ? (m >> 13) : 4) * NMODC;
        f32x4 sh[4], scl[4];
#pragma unroll
        for (int j = 0; j < 4; ++j) { const int c = 4 * lane + 256 * j; sh[j] = *(const f32x4*)(mr + shift_i * 1024 + c); scl[j] = *(const f32x4*)(mr + scale_i * 1024 + c); }
        float s = 0.f;
#pragma unroll
        for (int j = 0; j < 4; ++j) s += (v[j].x * v[j].x + v[j].y * v[j].y) + (v[j].z * v[j].z + v[j].w * v[j].w);
        const float rs = rsqf(wave_sum(s) * (1.f / DM) + EPS);
#pragma unroll
        for (int j = 0; j < 4; ++j) { const int c = 4 * lane + 256 * j;
            const f32x4 y = (v[j] * rs * wv[j]) * (scl[j] + 1.0f) + sh[j];
            u32x2 o; o.x = pk2(y.x, y.y); o.y = pk2(y.z, y.w);
            *(u32x2*)(out + (size_t)m * DM + c) = o; }
    }
}
constexpr size_t WS_QCX = 430 * MiB, CTX_STRIDE = (size_t)1024 * 1024;
constexpr size_t WS_BEU = 440 * MiB;
constexpr size_t WS_DUMMY = 396 * MiB;
__device__ __forceinline__ void mla_prenorm(const Args& a, int lane, int wave, bool dry) {
    bf16_t* CQ = (bf16_t*)(a.ws + WS_CQ); bf16_t* CKV = (bf16_t*)(a.ws + WS_CKV); bf16_t* CQo = dry ? (bf16_t*)(a.ws + WS_DUMMY) : CQ; bf16_t* CKVo = dry ? (bf16_t*)(a.ws + WS_DUMMY + 26 * MiB) : CKV;
    const float* qn = a.in[13]; const float* kn = a.in[14];
    const int gw = blockIdx.x * NWAVES + wave, NGW = gridDim.x * NWAVES;
    const int lq = lane < 48 ? lane : 0, lk = lane < 32 ? lane : 0;
    float qw[8], kw[8];
    { const f32x4 a0 = *(const f32x4*)(qn + lq * 8), a1 = *(const f32x4*)(qn + lq * 8 + 4), b0 = *(const f32x4*)(kn + lk * 8), b1 = *(const f32x4*)(kn + lk * 8 + 4);
      qw[0] = a0.x; qw[1] = a0.y; qw[2] = a0.z; qw[3] = a0.w; qw[4] = a1.x; qw[5] = a1.y; qw[6] = a1.z; qw[7] = a1.w; kw[0] = b0.x; kw[1] = b0.y; kw[2] = b0.z; kw[3] = b0.w; kw[4] = b1.x; kw[5] = b1.y; kw[6] = b1.z; kw[7] = b1.w; }
#pragma unroll 1
    for (int m0 = gw; m0 < MT; m0 += 4 * NGW) {
        u32x4 wq[4], wk[4];
#pragma unroll
        for (int k = 0; k < 4; ++k) { const int m = (m0 + k * NGW < MT) ? m0 + k * NGW : m0; wq[k] = *(const u32x4*)(CQ + (size_t)m * 384 + lq * 8); wk[k] = *(const u32x4*)(CKV + (size_t)m * 256 + lk * 8); }
#pragma unroll
        for (int k = 0; k < 4; ++k) { const int m = m0 + k * NGW; const bool ok = m < MT;
            float f[8]; float s = 0.f; unpack8(wq[k], f);
#pragma unroll
            for (int i = 0; i < 8; ++i) s += f[i] * f[i];
            if (lane >= 48) s = 0.f;
            float rs = rsqf(wave_sum(s) * (1.f / 384.f) + EPS);
            if (ok && lane < 48) {
#pragma unroll
                for (int i = 0; i < 8; ++i) f[i] = f[i] * rs * qw[i];
                *(u32x4*)(CQo + (size_t)m * 384 + lane * 8) = pack8f(f); }
            s = 0.f; unpack8(wk[k], f);
#pragma unroll
            for (int i = 0; i < 8; ++i) s += f[i] * f[i];
            if (lane >= 32) s = 0.f;
            rs = rsqf(wave_sum(s) * (1.f / 256.f) + EPS);
            if (ok && lane < 32) {
#pragma unroll
                for (int i = 0; i < 8; ++i) f[i] = f[i] * rs * kw[i];
                *(u32x4*)(CKVo + (size_t)m * 256 + lane * 8) = pack8f(f); } }
    }
}
__device__ __forceinline__ void rope_norm8(float* f, float ss_half, const float* nrm8, int pc, bool act, bool do_rope, const float* c8, const float* s8) {
    const float rs = rsqf(ss_half * (1.f / 192.f) + EPS);
    float y[8];
#pragma unroll
    for (int i = 0; i < 8; ++i) y[i] = act ? f[i] * rs * nrm8[i] : 0.f;
    const int part = ((pc - 16) >> 1) & 1;
#pragma unroll
    for (int i = 0; i < 8; ++i) {
        const float other = __shfl_xor(y[i], 2);
        const float r = part ? (y[i] * c8[i] + other * s8[i]) : (y[i] * c8[i] - other * s8[i]);
        f[i] = (act && do_rope && pc >= 16) ? r : y[i];
    }
}
__device__ __forceinline__ void mla_finish(const Args& a, int lane, int wave, bool dry) {
    bf16_t* Q = (bf16_t*)a.out; const size_t dmask = dry ? (size_t)8191 : ~(size_t)0; bf16_t* Qo = dry ? (bf16_t*)(a.ws + WS_DUMMY) : Q; const bf16_t* KV = (const bf16_t*)(a.ws + WS_KVRAW); const bf16_t* KR = (const bf16_t*)(a.ws + WS_KR); bf16_t* KF = dry ? (bf16_t*)(a.ws + WS_DUMMY + 24 * MiB) : (bf16_t*)(a.ws + WS_KF);
    const float* qnm = a.in[17]; const float* knm = a.in[18]; const float* rtab = (const float*)(a.ws + WS_ROPE);
    const int gw = blockIdx.x * NWAVES + wave, NGW = gridDim.x * NWAVES;
    const int l32 = lane & 31, half = lane >> 5; const bool act = l32 < 24; const int pc = act ? l32 : 0, pcn = pc < 16 ? pc : 0, pcr = pc >= 16 ? pc - 16 : 0;
    float qw[8], kw[8];
    { const f32x4 a0 = *(const f32x4*)(qnm + pc * 8), a1 = *(const f32x4*)(qnm + pc * 8 + 4), b0 = *(const f32x4*)(knm + pc * 8), b1 = *(const f32x4*)(knm + pc * 8 + 4);
      qw[0] = a0.x; qw[1] = a0.y; qw[2] = a0.z; qw[3] = a0.w; qw[4] = a1.x; qw[5] = a1.y; qw[6] = a1.z; qw[7] = a1.w; kw[0] = b0.x; kw[1] = b0.y; kw[2] = b0.z; kw[3] = b0.w; kw[4] = b1.x; kw[5] = b1.y; kw[6] = b1.z; kw[7] = b1.w; }
#pragma unroll 1
    for (int m = gw; m < MT; m += NGW) {
        const bool lat = m < ML; const size_t mq = lat ? (size_t)m : 0;
        u32x4 wq[4], wkv[4];
#pragma unroll
        for (int hp = 0; hp < 4; ++hp) { const int h = 2 * hp + half; wq[hp] = *(const u32x4*)(Q + mq * 1536 + h * 192 + pc * 8); wkv[hp] = *(const u32x4*)(KV + (size_t)m * 2048 + h * 256 + pcn * 8); }
        const u32x4 krw = *(const u32x4*)(KR + (size_t)m * 64 + pcr * 8);
        const int t = m & (SEQ - 1); const int pos = (pcr >> 2) ? (t & 63) : (t >> 6); const float* tp = rtab + pos * 16 + (pc & 1) * 8;
        const f32x4 ca = *(const f32x4*)tp, cb = *(const f32x4*)(tp + 4), sa = *(const f32x4*)(tp + 2048), sb = *(const f32x4*)(tp + 2052);
        const bool rp = lat && act && pc >= 16;
        const float c8[8] = {rp ? ca.x : 1.f, rp ? ca.y : 1.f, rp ? ca.z : 1.f, rp ? ca.w : 1.f, rp ? cb.x : 1.f, rp ? cb.y : 1.f, rp ? cb.z : 1.f, rp ? cb.w : 1.f};
        const float s8[8] = {rp ? sa.x : 0.f, rp ? sa.y : 0.f, rp ? sa.z : 0.f, rp ? sa.w : 0.f, rp ? sb.x : 0.f, rp ? sb.y : 0.f, rp ? sb.z : 0.f, rp ? sb.w : 0.f};
#pragma unroll
        for (int hp = 0; hp < 4; ++hp) {
            const int h = 2 * hp + half;
            if (lat) {
                float f[8]; unpack8(wq[hp], f); float s = 0.f;
#pragma unroll
                for (int i = 0; i < 8; ++i) s += f[i] * f[i];
                if (!act) s = 0.f;
#pragma unroll
                for (int o = 1; o < 32; o <<= 1) s += __shfl_xor(s, o);
                rope_norm8(f, s, qw, pc, act, true, c8, s8);
                if (act) *(u32x4*)(Qo + ((size_t)m & dmask) * 1536 + h * 192 + pc * 8) = pack8f(f);
            }
            {
                float f[8]; unpack8(pc < 16 ? wkv[hp] : krw, f); float s = 0.f;
#pragma unroll
                for (int i = 0; i < 8; ++i) s += f[i] * f[i];
                if (!act) s = 0.f;
#pragma unroll
                for (int o = 1; o < 32; o <<= 1) s += __shfl_xor(s, o);
                rope_norm8(f, s, kw, pc, act, lat, c8, s8);
                if (act) *(u32x4*)(KF + ((size_t)m & dmask) * 1536 + h * 192 + pc * 8) = pack8f(f);
            }
        }
    }
}
__device__ __forceinline__ void halo_save(const Args& a, int tid) {
    const bf16_t* QKV = (const bf16_t*)(a.ws + WS_QR); bf16_t* HALO = (bf16_t*)(a.ws + WS_HALO);
    for (int idx = blockIdx.x * NTHR + tid; idx < (MT / 64) * 1536; idx += gridDim.x * NTHR) {
        const int g = idx / 1536, rem = idx % 1536, slot = rem / 384, arr = (rem % 384) >> 7, pcs = rem & 127;
        const int row = g * 64 + (slot < 2 ? slot : 60 + slot);
        *(u32x4*)(HALO + (((size_t)g * 4 + slot) * 3 + arr) * 1024 + pcs * 8) = *(const u32x4*)(QKV + (size_t)arr * QKV_STRIDE + (size_t)row * 1024 + pcs * 8);
    }
}
constexpr int PR_RAW = 0, PR_KN = 53312, PR_G = 70720, PR_GC = 87360, PR_CW = 88576;
#define PR_DECODE(u_, b_, h_, c_, nch_, rb_) do { if ((u_) < 4096) { b_ = (u_) >> 10; h_ = ((u_) >> 7) & 7; c_ = (u_) & 127; nch_ = 128; rb_ = b_ * SEQ + c_ * 64; } \
        else { const int v_ = (u_) - 4096; b_ = v_ >> 5; h_ = (v_ >> 2) & 7; c_ = v_ & 3; nch_ = 4; rb_ = ML + b_ * CTXL + c_ * 64; } } while (0)
__device__ __forceinline__ void gdn_prep(const Args& a, LAS unsigned char* lds, int tid, int lane, int wave, bool dry) {
    unsigned char* ws = a.ws;
    bf16_t* QKV = (bf16_t*)(ws + WS_QR); bf16_t* QCX = (bf16_t*)(ws + WS_QCX); const bf16_t* HALO = (const bf16_t*)(ws + WS_HALO); const float* BD = (const float*)(ws + WS_BD);
    float* GCU = (float*)(ws + WS_GCU); float* BTU = (float*)(ws + WS_BTU); float* BEU = (float*)(ws + WS_BEU); bf16_t* TL = (bf16_t*)a.out; bf16_t* TC = (bf16_t*)(ws + WS_TCTX);
    const float* convw = a.in[9]; const float* a_log = a.in[10]; const float* dt_bias = a.in[11];
    LAS bf16_t* raw = (LAS bf16_t*)(lds + PR_RAW); LAS bf16_t* kn = (LAS bf16_t*)(lds + PR_KN); LAS float* Gs = (LAS float*)(lds + PR_G);
    LAS float* gcs = (LAS float*)(lds + PR_GC); LAS float* bts = gcs + 128;
    const int r32 = lane & 31, hi = lane >> 5;
#define LBAR() do { asm volatile("s_waitcnt lgkmcnt(0)" ::: "memory"); __builtin_amdgcn_s_barrier(); asm volatile("" ::: "memory"); } while (0)
    u32x4 pr[7];
#define PR_LOADRAW(u_) do { int b_, h_, c_, nch_, rb_; PR_DECODE(u_, b_, h_, c_, nch_, rb_); const int g_ = rb_ >> 6; \
        const bf16_t* qkvb_ = (u_) < 4096 ? QKV : QCX - (size_t)ML * 1024; const size_t qst_ = (u_) < 4096 ? QKV_STRIDE : CTX_STRIDE; \
        _Pragma("unroll") for (int k_ = 0; k_ < 7; ++k_) { const int p_ = tid + 512 * k_; const int lr_ = p_ / 48, pc_ = p_ % 48, arr_ = pc_ >> 4, chp_ = pc_ & 15, i_ = lr_ - 2; \
            u32x4 w_ = {0u, 0u, 0u, 0u}; \
            if (p_ < 68 * 48) { \
                if (i_ >= 0 && i_ < 64) w_ = *(const u32x4*)(qkvb_ + (size_t)arr_ * qst_ + (size_t)(rb_ + i_) * 1024 + h_ * 128 + chp_ * 8); \
                else if (i_ < 0) { if (c_ > 0) w_ = *(const u32x4*)(HALO + (((size_t)(g_ - 1) * 4 + (2 + lr_)) * 3 + arr_) * 1024 + h_ * 128 + chp_ * 8); } \
                else { if (c_ < nch_ - 1) w_ = *(const u32x4*)(HALO + (((size_t)(g_ + 1) * 4 + (i_ - 64)) * 3 + arr_) * 1024 + h_ * 128 + chp_ * 8); } } \
            pr[k_] = w_; } } while (0)
    if ((int)blockIdx.x < 4224) PR_LOADRAW((int)blockIdx.x);
    LAS float* cws = (LAS float*)(lds + PR_CW);
    for (int i = tid; i < 5 * 3072 / 4; i += NTHR) *(LAS f32x4*)(cws + i * 4) = *(const f32x4*)(convw + i * 4);
#pragma unroll 1
    for (int u = blockIdx.x; u < 4224; u += gridDim.x) {
        int b, h, c, nch, rowbase; PR_DECODE(u, b, h, c, nch, rowbase); (void)c; (void)nch;
#pragma unroll
        for (int k = 0; k < 7; ++k) { const int p = tid + 512 * k, lr = p / 48, pc = p % 48; if (p < 68 * 48) *(LAS u32x4*)(raw + lr * 392 + pc * 8) = pr[k]; }
        LBAR();
        if (u + (int)gridDim.x < 4224) PR_LOADRAW(u + (int)gridDim.x);
        float bd_bl = 0.f, bd_dl = 0.f, bd_al = 0.f, bd_dt = 0.f;
        if (wave == 4 || wave == 5) { const int dir = wave - 4, dh = dir * 8 + h, ti = dir ? 63 - lane : lane; const size_t m = (size_t)rowbase + ti; bd_bl = BD[m * 32 + dh]; bd_dl = BD[m * 32 + 16 + dh]; bd_al = a_log[dh]; bd_dt = dt_bias[dh]; }
        { const int cgi = tid & 15, tsl = tid >> 4;
#pragma unroll
          for (int arr = 0; arr < 3; ++arr) {
            float wv[5][8];
#pragma unroll
            for (int tap = 0; tap < 5; ++tap) { const LAS float* wp = cws + tap * 3072 + arr * 1024 + h * 128 + cgi * 8; const f32x4 w0 = *(const LAS f32x4*)wp, w1 = *(const LAS f32x4*)(wp + 4);
                wv[tap][0] = w0.x; wv[tap][1] = w0.y; wv[tap][2] = w0.z; wv[tap][3] = w0.w; wv[tap][4] = w1.x; wv[tap][5] = w1.y; wv[tap][6] = w1.z; wv[tap][7] = w1.w; }
#pragma unroll
            for (int tt = 0; tt < 2; ++tt) {
                const int tok = tsl + 32 * tt;
                float acc[8];
#pragma unroll
                for (int e = 0; e < 8; ++e) acc[e] = 0.f;
#pragma unroll
                for (int tap = 0; tap < 5; ++tap) { const u32x4 w = *(const LAS u32x4*)(raw + (tok + tap) * 392 + arr * 128 + cgi * 8); float f[8]; unpack8(w, f);
#pragma unroll
                    for (int e = 0; e < 8; ++e) acc[e] += f[e] * wv[tap][e]; }
                float ss = 0.f;
#pragma unroll
                for (int e = 0; e < 8; ++e) { acc[e] = siluf(acc[e]); ss += acc[e] * acc[e]; }
                ss += __shfl_xor(ss, 1); ss += __shfl_xor(ss, 2); ss += __shfl_xor(ss, 4); ss += __shfl_xor(ss, 8);
                if (arr < 2) { const float rn = rsqf(ss + EPS);
#pragma unroll
                    for (int e = 0; e < 8; ++e) acc[e] *= rn; }
                const u32x4 o = pack8f(acc);
                if (dry) *(u32x4*)((bf16_t*)(ws + WS_DUMMY) + (size_t)arr * 8192 * 1024 + (size_t)((rowbase + tok) & 8191) * 1024 + h * 128 + cgi * 8) = o;
                else *(u32x4*)((u < 4096 ? QKV : QCX - (size_t)ML * 1024) + (size_t)arr * (u < 4096 ? QKV_STRIDE : CTX_STRIDE) + (size_t)(rowbase + tok) * 1024 + h * 128 + cgi * 8) = o;
                if (arr == 1) *(LAS u32x4*)(kn + tok * 136 + cgi * 8) = o;
            }
          } }
        LBAR();
        if (wave < 4) {
            const int it = wave >> 1, jt = wave & 1; f32x16 acc = {};
#pragma unroll
            for (int ks = 0; ks < 8; ++ks) { const bf16x8 av = *(const LAS bf16x8*)(kn + (it * 32 + r32) * 136 + ks * 16 + hi * 8), bv = *(const LAS bf16x8*)(kn + (jt * 32 + r32) * 136 + ks * 16 + hi * 8); acc = MFMA32(av, bv, acc); }
#pragma unroll
            for (int r = 0; r < 16; ++r) Gs[(it * 32 + crow(r, hi)) * 65 + jt * 32 + r32] = acc[r];
        } else if (wave < 6) {
            const int dir = wave - 4;
            const float beta = 1.f / (1.f + expf(-bd_bl));
            const float xx = bd_dl + bd_dt; const float sp = xx > 20.f ? xx : log1pf(expf(xx));
            float gcum = -expf(bd_al) * sp;
#pragma unroll
            for (int o = 1; o < 64; o <<= 1) { const float t = __shfl_up(gcum, o); if (lane >= o) gcum += t; }
            gcs[dir * 64 + lane] = gcum; bts[dir * 64 + lane] = beta;
            GCU[((size_t)u * 2 + dir) * 64 + lane] = gcum; BTU[((size_t)u * 2 + dir) * 64 + lane] = beta; BEU[((size_t)u * 2 + dir) * 64 + lane] = beta * expf(gcum);
        }
        LBAR();
        { bf16_t* Tg = (u < 4096 ? TL + (size_t)u * 8192 : TC + (size_t)(u - 4096) * 8192);
          const int e0 = tid * 16, dir = e0 >> 12, i = (e0 >> 6) & 63, j0 = e0 & 63, ti = dir ? 63 - i : i; const float bi = bts[dir * 64 + i], gi = gcs[dir * 64 + i];
          float v[16];
#pragma unroll
          for (int jj = 0; jj < 16; ++jj) { const int j = j0 + jj, tj = dir ? 63 - j : j; v[jj] = (j < i) ? bi * Gs[ti * 65 + tj] * __expf(fminf(gi - gcs[dir * 64 + j], 0.f)) : 0.f; }
          *(u32x4*)(Tg + e0) = pack8f(v); *(u32x4*)(Tg + e0 + 8) = pack8f(v + 8); }
    }
    __syncthreads();
    { LAS float* A = (LAS float*)(lds + wave * 16384);
      const int nun = (4224 - (int)blockIdx.x + (int)gridDim.x - 1) / (int)gridDim.x;
      u32x4 an[8];
      { const int it0 = wave < 2 * nun ? wave : 0; const int u0 = blockIdx.x + (it0 >> 1) * gridDim.x; const bf16_t* Tg0 = (u0 < 4096 ? TL + (size_t)u0 * 8192 : TC + (size_t)(u0 - 4096) * 8192) + (it0 & 1) * 4096;
#pragma unroll
        for (int k = 0; k < 8; ++k) an[k] = *(const u32x4*)(Tg0 + (lane + 64 * k) * 8); }
#pragma unroll 1
      for (int it = wave; it < 2 * nun; it += NWAVES) {
        const int u = blockIdx.x + (it >> 1) * gridDim.x, dir = it & 1;
        bf16_t* Tg = (u < 4096 ? TL + (size_t)u * 8192 : TC + (size_t)(u - 4096) * 8192) + dir * 4096;
#pragma unroll
        for (int k = 0; k < 8; ++k) { const int p = lane + 64 * k; float f[8]; unpack8(an[k], f);
            *(LAS f32x4*)(A + p * 8) = (f32x4){f[0], f[1], f[2], f[3]}; *(LAS f32x4*)(A + p * 8 + 4) = (f32x4){f[4], f[5], f[6], f[7]}; }
        { const int itn = (it + NWAVES < 2 * nun) ? it + NWAVES : it; const int un = blockIdx.x + (itn >> 1) * gridDim.x; const bf16_t* Tgn = (un < 4096 ? TL + (size_t)un * 8192 : TC + (size_t)(un - 4096) * 8192) + (itn & 1) * 4096;
#pragma unroll
          for (int k = 0; k < 8; ++k) an[k] = *(const u32x4*)(Tgn + (lane + 64 * k) * 8); }
        LDS_WAIT(); asm volatile("" ::: "memory");
        float t[64];
#pragma unroll
        for (int i = 0; i < 64; ++i) {
            float acc = (lane == i) ? 1.f : 0.f, ac1 = 0.f, ac2 = 0.f, ac3 = 0.f;
#pragma unroll
            for (int j4 = 0; j4 < (i + 3) / 4; ++j4) { const f32x4 a4 = *(const LAS f32x4*)(A + i * 64 + 4 * j4);
                if (4 * j4 + 0 < i) acc -= a4.x * t[4 * j4 + 0];
                if (4 * j4 + 1 < i) ac1 -= a4.y * t[4 * j4 + 1];
                if (4 * j4 + 2 < i) ac2 -= a4.z * t[4 * j4 + 2];
                if (4 * j4 + 3 < i) ac3 -= a4.w * t[4 * j4 + 3]; }
            acc = (acc + ac1) + (ac2 + ac3);
            t[i] = acc;
            Tg[i * 64 + lane] = f2bf(acc);
        }
        LDS_WAIT(); asm volatile("" ::: "memory");
      } }
    __syncthreads();
#undef LBAR
#undef PR_LOADRAW
}
constexpr int CH_QS = 0, CH_KS = 17408, CH_KT = 34816, CH_VT = 53248, CH_TP = 62464, CH_TPP = 71680, CH_W = 80896, CH_QK = 98304, CH_ST = 107520, CH_VN = 124928, CH_VND = 134144, CH_GC = 143360;
__device__ __forceinline__ void st4(LAS bf16_t* p, float a0, float a1, float a2, float a3) { u32x2 o; o.x = pk2(a0, a1); o.y = pk2(a2, a3); *(LAS u32x2*)p = o; }
__device__ __forceinline__ void gdn_chain(const Args& a, LAS unsigned char* lds, int tid, int lane, int wave) {
    if (blockIdx.x >= 128) return;
    unsigned char* ws = a.ws;
    const int w = (blockIdx.x & 7) * 16 + (blockIdx.x >> 3);
    const int b = w >> 5, h = (w >> 2) & 7, dir = (w >> 1) & 1, dvh = w & 1;
    const bf16_t* QR = (const bf16_t*)(ws + WS_QR); const bf16_t* KR = QR + QKV_STRIDE; const bf16_t* VR = QR + 2 * QKV_STRIDE;
    const float* GCU = (const float*)(ws + WS_GCU); const float* BTU = (const float*)(ws + WS_BTU); const bf16_t* TL = (const bf16_t*)a.out; const bf16_t* TC = (const bf16_t*)(ws + WS_TCTX);
    bf16_t* Od = dir ? (bf16_t*)a.out + (size_t)ML * 1024 : (bf16_t*)(ws + WS_OF);
    LAS bf16_t* qs = (LAS bf16_t*)(lds + CH_QS); LAS bf16_t* ks = (LAS bf16_t*)(lds + CH_KS); LAS bf16_t* kT = (LAS bf16_t*)(lds + CH_KT); LAS bf16_t* vT = (LAS bf16_t*)(lds + CH_VT);
    LAS bf16_t* Tp = (LAS bf16_t*)(lds + CH_TP); LAS bf16_t* Tpp = (LAS bf16_t*)(lds + CH_TPP); LAS bf16_t* wsm = (LAS bf16_t*)(lds + CH_W); LAS bf16_t* qk = (LAS bf16_t*)(lds + CH_QK);
    LAS bf16_t* ST = (LAS bf16_t*)(lds + CH_ST); LAS bf16_t* vn = (LAS bf16_t*)(lds + CH_VN); LAS bf16_t* vnd = (LAS bf16_t*)(lds + CH_VND); LAS float* gcs = (LAS float*)(lds + CH_GC);
    const int r32 = lane & 31, hi = lane >> 5;
    const float scale = 0.08838834764831845f;
    for (int i = tid; i < 64 * 136 / 8; i += NTHR) *(LAS u32x4*)(ST + i * 8) = (u32x4){0u, 0u, 0u, 0u};
    f32x16 Sacc = {};
    __syncthreads();
#define LBAR() do { asm volatile("s_waitcnt lgkmcnt(0)" ::: "memory"); __builtin_amdgcn_s_barrier(); asm volatile("" ::: "memory"); } while (0)
#define CH_UNIT(s_, u_, rb_, lat_) do { if ((s_) < 4) { const int cc_ = dir ? 3 - (s_) : (s_); u_ = 4096 + (b * 8 + h) * 4 + cc_; rb_ = ML + b * CTXL + cc_ * 64; lat_ = false; } \
        else { const int cc_ = dir ? 131 - (s_) : (s_) - 4; u_ = (b * 8 + h) * 128 + cc_; rb_ = b * SEQ + cc_ * 64; lat_ = true; } } while (0)
#define CH_LOAD(s_) do { int u_, rb_; bool lat_; CH_UNIT(s_, u_, rb_, lat_); \
        const bf16_t* Tg_ = (lat_ ? TL + (size_t)u_ * 8192 : TC + (size_t)(u_ - 4096) * 8192) + dir * 4096; \
        const float* gcu_ = GCU + ((size_t)u_ * 2 + dir) * 64; const float* btu_ = BTU + ((size_t)u_ * 2 + dir) * 64; \
        { const int ti_ = tid & 63, cg_ = tid >> 6; const size_t r0_ = (size_t)rb_ + (dir ? 63 - ti_ : ti_); \
          const bf16_t* qs_ = lat_ ? QR : (const bf16_t*)(ws + WS_QCX) - (size_t)ML * 1024; const size_t st_ = lat_ ? QKV_STRIDE : CTX_STRIDE; \
          pq0 = *(const u32x4*)(qs_ + r0_ * 1024 + h * 128 + cg_ * 8); pq1 = *(const u32x4*)(qs_ + r0_ * 1024 + h * 128 + 64 + cg_ * 8); \
          pk0 = *(const u32x4*)(qs_ + st_ + r0_ * 1024 + h * 128 + cg_ * 8); pk1 = *(const u32x4*)(qs_ + st_ + r0_ * 1024 + h * 128 + 64 + cg_ * 8); \
          pv0 = *(const u32x4*)(qs_ + 2 * st_ + r0_ * 1024 + h * 128 + dvh * 64 + cg_ * 8); } \
        { const int i_ = tid >> 3, j0_ = (tid & 7) * 8; pt0 = *(const u32x4*)(Tg_ + i_ * 64 + j0_); \
          pg0 = *(const f32x4*)(gcu_ + j0_); pg1 = *(const f32x4*)(gcu_ + j0_ + 4); pb0 = *(const f32x4*)(btu_ + j0_); pb1 = *(const f32x4*)(btu_ + j0_ + 4); } \
        pgc = gcu_[tid & 63]; pgl = gcu_[63]; } while (0)
#define CH_OSTORE(prow_) do { if (wave >= 4 && (prow_) >= 0) { const int it_ = (wave - 4) >> 1, dvt_ = (wave - 4) & 1; \
        _Pragma("unroll") for (int r = 0; r < 16; ++r) { const int i_ = it_ * 32 + crow(r, hi); const size_t row_ = (size_t)(prow_) + (dir ? 63 - i_ : i_); Od[row_ * 1024 + h * 128 + dvh * 64 + dvt_ * 32 + r32] = f2bf(oprev[r]); } } } while (0)
    u32x4 pq0, pq1, pk0, pk1, pv0, pt0; f32x4 pg0, pg1, pb0, pb1; float pgc, pgl; f32x16 oprev = {}; int prow = -1;
    CH_LOAD(0);
#pragma unroll 1
    for (int s = 0; s < 132; ++s) {
        int u, rowbase; bool lat; CH_UNIT(s, u, rowbase, lat); (void)u;
#pragma unroll
        for (int e2 = 0; e2 < 2; ++e2) { const int ti = tid & 63, cg = (tid >> 6) + 8 * e2;
            const u32x4 qv = e2 ? pq1 : pq0; *(LAS u32x4*)(qs + ti * 136 + cg * 8) = qv;
            const u32x4 kv = e2 ? pk1 : pk0; *(LAS u32x4*)(ks + ti * 136 + cg * 8) = kv;
            LAS bf16_t* kt = kT + (cg * 8) * 72 + ti;
            kt[0 * 72] = (bf16_t)(kv.x & 0xffffu); kt[1 * 72] = (bf16_t)(kv.x >> 16); kt[2 * 72] = (bf16_t)(kv.y & 0xffffu); kt[3 * 72] = (bf16_t)(kv.y >> 16);
            kt[4 * 72] = (bf16_t)(kv.z & 0xffffu); kt[5 * 72] = (bf16_t)(kv.z >> 16); kt[6 * 72] = (bf16_t)(kv.w & 0xffffu); kt[7 * 72] = (bf16_t)(kv.w >> 16); }
        { const int ti = tid & 63, cg = tid >> 6; const u32x4 vv = pv0;
            LAS bf16_t* vt = vT + (cg * 8) * 72 + ti;
            vt[0 * 72] = (bf16_t)(vv.x & 0xffffu); vt[1 * 72] = (bf16_t)(vv.x >> 16); vt[2 * 72] = (bf16_t)(vv.y & 0xffffu); vt[3 * 72] = (bf16_t)(vv.y >> 16);
            vt[4 * 72] = (bf16_t)(vv.z & 0xffffu); vt[5 * 72] = (bf16_t)(vv.z >> 16); vt[6 * 72] = (bf16_t)(vv.w & 0xffffu); vt[7 * 72] = (bf16_t)(vv.w >> 16); }
        { const int i = tid >> 3, j0 = (tid & 7) * 8; float tf[8], f1[8], f2[8]; unpack8(pt0, tf);
            const float gg[8] = {pg0.x, pg0.y, pg0.z, pg0.w, pg1.x, pg1.y, pg1.z, pg1.w}, bb[8] = {pb0.x, pb0.y, pb0.z, pb0.w, pb1.x, pb1.y, pb1.z, pb1.w};
#pragma unroll
            for (int e = 0; e < 8; ++e) { f2[e] = tf[e] * bb[e]; f1[e] = f2[e] * __expf(gg[e]); }
            *(LAS u32x4*)(Tp + i * 72 + j0) = pack8f(f1); *(LAS u32x4*)(Tpp + i * 72 + j0) = pack8f(f2); }
        if (tid < 64) gcs[tid] = pgc;
        float gc63 = pgl; asm volatile("" : "+v"(gc63));
        const float gl = __expf(gc63);
        LBAR();
        CH_OSTORE(prow);
        prow = lat ? rowbase : -1;
        if (s + 1 < 132) CH_LOAD(s + 1);
        f32x16 uacc = {};
        if (wave < 4) { const int it = wave >> 1, dvt = wave & 1;
{ bf16x8 fa_[4], fb_[4];
#pragma unroll
            for (int kk = 0; kk < 4; ++kk) { fa_[kk] = *(const LAS bf16x8*)(Tpp + (it * 32 + r32) * 72 + kk * 16 + hi * 8); fb_[kk] = *(const LAS bf16x8*)(vT + (dvt * 32 + r32) * 72 + kk * 16 + hi * 8); }
            __builtin_amdgcn_sched_barrier(0);
#pragma unroll
            for (int kk = 0; kk < 4; ++kk) uacc = MFMA32(fa_[kk], fb_[kk], uacc); } }
        { const int dkt = wave >> 1, it = wave & 1; f32x16 acc = {};
{ bf16x8 fa_[4], fb_[4];
#pragma unroll
            for (int kk = 0; kk < 4; ++kk) { fa_[kk] = *(const LAS bf16x8*)(kT + (dkt * 32 + r32) * 72 + kk * 16 + hi * 8); fb_[kk] = *(const LAS bf16x8*)(Tp + (it * 32 + r32) * 72 + kk * 16 + hi * 8); }
            __builtin_amdgcn_sched_barrier(0);
#pragma unroll
            for (int kk = 0; kk < 4; ++kk) acc = MFMA32(fa_[kk], fb_[kk], acc); }
#pragma unroll
            for (int g = 0; g < 4; ++g) st4(wsm + (it * 32 + r32) * 136 + dkt * 32 + 8 * g + 4 * hi, acc[4 * g], acc[4 * g + 1], acc[4 * g + 2], acc[4 * g + 3]); }
        if (wave >= 4) { const int it = (wave - 4) >> 1, jt = (wave - 4) & 1; f32x16 acc = {};
            if (jt <= it) {
{
#pragma unroll
                for (int kh = 0; kh < 2; ++kh) { bf16x8 fa_[4], fb_[4];
#pragma unroll
                for (int k4 = 0; k4 < 4; ++k4) { const int kk = kh * 4 + k4; fa_[k4] = *(const LAS bf16x8*)(ks + (jt * 32 + r32) * 136 + kk * 16 + hi * 8); fb_[k4] = *(const LAS bf16x8*)(qs + (it * 32 + r32) * 136 + kk * 16 + hi * 8); }
                __builtin_amdgcn_sched_barrier(0);
#pragma unroll
                for (int k4 = 0; k4 < 4; ++k4) acc = MFMA32(fa_[k4], fb_[k4], acc); } } }
            const int i = it * 32 + r32; const float gi = gcs[i];
#pragma unroll
            for (int g = 0; g < 4; ++g) { float v[4]; const int jb = jt * 32 + 8 * g + 4 * hi; const f32x4 gj = *(const LAS f32x4*)(gcs + jb);
                v[0] = (jb + 0 <= i) ? acc[4 * g + 0] * scale * __expf(fminf(gi - gj.x, 0.f)) : 0.f; v[1] = (jb + 1 <= i) ? acc[4 * g + 1] * scale * __expf(fminf(gi - gj.y, 0.f)) : 0.f;
                v[2] = (jb + 2 <= i) ? acc[4 * g + 2] * scale * __expf(fminf(gi - gj.z, 0.f)) : 0.f; v[3] = (jb + 3 <= i) ? acc[4 * g + 3] * scale * __expf(fminf(gi - gj.w, 0.f)) : 0.f;
                st4(qk + i * 72 + jb, v[0], v[1], v[2], v[3]); } }
        LBAR();
        f32x16 qS = {};
        if (wave < 4) { const int it = wave >> 1, dvt = wave & 1; f32x16 acc = {};
{
#pragma unroll
            for (int kh = 0; kh < 2; ++kh) { bf16x8 fa_[4], fb_[4];
#pragma unroll
            for (int k4 = 0; k4 < 4; ++k4) { const int kk = kh * 4 + k4; fa_[k4] = *(const LAS bf16x8*)(wsm + (it * 32 + r32) * 136 + kk * 16 + hi * 8); fb_[k4] = *(const LAS bf16x8*)(ST + (dvt * 32 + r32) * 136 + kk * 16 + hi * 8); }
            __builtin_amdgcn_sched_barrier(0);
#pragma unroll
            for (int k4 = 0; k4 < 4; ++k4) acc = MFMA32(fa_[k4], fb_[k4], acc); } }
#pragma unroll
            for (int g = 0; g < 4; ++g) { float v[4], vd[4]; const f32x4 gi4 = *(const LAS f32x4*)(gcs + it * 32 + 8 * g + 4 * hi); const float gia[4] = {gi4.x, gi4.y, gi4.z, gi4.w};
#pragma unroll
                for (int k = 0; k < 4; ++k) { v[k] = uacc[4 * g + k] - acc[4 * g + k]; vd[k] = v[k] * __expf(gc63 - gia[k]); }
                st4(vn + (dvt * 32 + r32) * 72 + it * 32 + 8 * g + 4 * hi, v[0], v[1], v[2], v[3]); st4(vnd + (dvt * 32 + r32) * 72 + it * 32 + 8 * g + 4 * hi, vd[0], vd[1], vd[2], vd[3]); }
        } else { const int it = (wave - 4) >> 1, dvt = (wave - 4) & 1;
{
#pragma unroll
            for (int kh = 0; kh < 2; ++kh) { bf16x8 fa_[4], fb_[4];
#pragma unroll
            for (int k4 = 0; k4 < 4; ++k4) { const int kk = kh * 4 + k4; fa_[k4] = *(const LAS bf16x8*)(qs + (it * 32 + r32) * 136 + kk * 16 + hi * 8); fb_[k4] = *(const LAS bf16x8*)(ST + (dvt * 32 + r32) * 136 + kk * 16 + hi * 8); }
            __builtin_amdgcn_sched_barrier(0);
#pragma unroll
            for (int k4 = 0; k4 < 4; ++k4) qS = MFMA32(fa_[k4], fb_[k4], qS); } }
#pragma unroll
            for (int g = 0; g < 4; ++g) { const f32x4 gi4 = *(const LAS f32x4*)(gcs + it * 32 + 8 * g + 4 * hi);
                qS[4 * g + 0] *= scale * __expf(gi4.x); qS[4 * g + 1] *= scale * __expf(gi4.y); qS[4 * g + 2] *= scale * __expf(gi4.z); qS[4 * g + 3] *= scale * __expf(gi4.w); } }
        LBAR();
        if (wave >= 4) { const int it = (wave - 4) >> 1, dvt = (wave - 4) & 1;
{ bf16x8 fa_[4], fb_[4];
#pragma unroll
            for (int kk = 0; kk < 4; ++kk) { fa_[kk] = *(const LAS bf16x8*)(qk + (it * 32 + r32) * 72 + kk * 16 + hi * 8); fb_[kk] = *(const LAS bf16x8*)(vn + (dvt * 32 + r32) * 72 + kk * 16 + hi * 8); }
            __builtin_amdgcn_sched_barrier(0);
#pragma unroll
            for (int kk = 0; kk < 4; ++kk) qS = MFMA32(fa_[kk], fb_[kk], qS); }
            oprev = qS; }
        { const int dkt = wave >> 1, dvt = wave & 1;
#pragma unroll
            for (int r = 0; r < 16; ++r) Sacc[r] *= gl;
{ bf16x8 fa_[4], fb_[4];
#pragma unroll
            for (int kk = 0; kk < 4; ++kk) { fa_[kk] = *(const LAS bf16x8*)(kT + (dkt * 32 + r32) * 72 + kk * 16 + hi * 8); fb_[kk] = *(const LAS bf16x8*)(vnd + (dvt * 32 + r32) * 72 + kk * 16 + hi * 8); }
            __builtin_amdgcn_sched_barrier(0);
#pragma unroll
            for (int kk = 0; kk < 4; ++kk) Sacc = MFMA32(fa_[kk], fb_[kk], Sacc); }
#pragma unroll
            for (int g = 0; g < 4; ++g) st4(ST + (dvt * 32 + r32) * 136 + dkt * 32 + 8 * g + 4 * hi, Sacc[4 * g], Sacc[4 * g + 1], Sacc[4 * g + 2], Sacc[4 * g + 3]); }
        LBAR();
    }
    CH_OSTORE(prow);
}
#undef CH_OSTORE
#undef LBAR
#undef CH_UNIT
#undef CH_LOAD
__device__ __forceinline__ void gdn_combine(const Args& a, int tid, bool dry) {
    bf16_t* OF = (bf16_t*)(a.ws + WS_OF); bf16_t* OFo = dry ? (bf16_t*)(a.ws + WS_DUMMY) : OF; const size_t dmask = dry ? (size_t)(16 * MiB - 1) : ~(size_t)0; const bf16_t* OB = (const bf16_t*)a.out + (size_t)ML * 1024; const bf16_t* Z = (const bf16_t*)(a.ws + WS_Z); const float* nw = a.in[12];
    const size_t total = (size_t)ML * 128, stride = (size_t)gridDim.x * NTHR;
    float nwv[8];
    { const int d0 = (tid & 15) * 8; const f32x4 n0 = *(const f32x4*)(nw + d0), n1 = *(const f32x4*)(nw + d0 + 4); nwv[0] = n0.x; nwv[1] = n0.y; nwv[2] = n0.z; nwv[3] = n0.w; nwv[4] = n1.x; nwv[5] = n1.y; nwv[6] = n1.z; nwv[7] = n1.w; }
#pragma unroll 1
    for (size_t idx0 = (size_t)blockIdx.x * NTHR + tid; idx0 < total; idx0 += 4 * stride) {
        u32x4 wf[4], wg[4], wz[4];
#pragma unroll
        for (int k = 0; k < 4; ++k) { const size_t idx = idx0 + k * stride, off = (idx < total ? idx : idx0) * 8; wf[k] = *(const u32x4*)(OF + off); wg[k] = *(const u32x4*)(OB + off); wz[k] = *(const u32x4*)(Z + off); }
#pragma unroll
        for (int k = 0; k < 4; ++k) { const size_t idx = idx0 + k * stride; const size_t off = idx * 8;
            float f[8], g[8], z[8]; unpack8(wf[k], f); unpack8(wg[k], g); unpack8(wz[k], z);
            float ss = 0.f;
#pragma unroll
            for (int e = 0; e < 8; ++e) { f[e] += g[e]; ss += f[e] * f[e]; }
            ss += __shfl_xor(ss, 1); ss += __shfl_xor(ss, 2); ss += __shfl_xor(ss, 4); ss += __shfl_xor(ss, 8);
            const float rs = rsqf(ss * (1.f / 128.f) + EPS);
#pragma unroll
            for (int e = 0; e < 8; ++e) f[e] = f[e] * rs * nwv[e] * siluf(z[e]);
            if (idx < total) *(u32x4*)(OFo + (off & dmask)) = pack8f(f); }
    }
}
constexpr int C2_QS = 0, C2_KT = 34816, C2_QK = 71680, C2_GC = 90112, C2_W = 90624, C2_UT = 108032, C2_KS = 112640, C2_VT = 130048, C2_TP = 134656, C2_TPP = 143872, C2_OL = 153088, C2_QL = 157696, C2_FAC = 162304, C2_END = 163328;
__device__ __forceinline__ bf16x8 rdfrag(const LAS bf16_t* p) { const u32x2 lo = *(const LAS u32x2*)p, h2 = *(const LAS u32x2*)(p + 8); const u32x4 w = {lo.x, lo.y, h2.x, h2.y}; return __builtin_bit_cast(bf16x8, w); }
#define PACKFRAG(x, s) __builtin_bit_cast(bf16x8, (u32x4){pk2((x)[8 * (s)], (x)[8 * (s) + 1]), pk2((x)[8 * (s) + 2], (x)[8 * (s) + 3]), pk2((x)[8 * (s) + 4], (x)[8 * (s) + 5]), pk2((x)[8 * (s) + 6], (x)[8 * (s) + 7])})
__device__ __forceinline__ void gdn_chain2(const Args& a, LAS unsigned char* lds, int tid, int lane, int wave) {
    unsigned char* ws = a.ws;
    const bf16_t* QR = (const bf16_t*)(ws + WS_QR); const bf16_t* KR = QR + QKV_STRIDE; const bf16_t* VR = QR + 2 * QKV_STRIDE;
    const float* GCU = (const float*)(ws + WS_GCU); const float* BTU = (const float*)(ws + WS_BTU); const float* BEU = (const float*)(ws + WS_BEU); const bf16_t* TL = (const bf16_t*)a.out; const bf16_t* TC = (const bf16_t*)(ws + WS_TCTX);
    LAS bf16_t* qs = (LAS bf16_t*)(lds + C2_QS); LAS bf16_t* kT = (LAS bf16_t*)(lds + C2_KT); LAS bf16_t* qk = (LAS bf16_t*)(lds + C2_QK); LAS float* gcs = (LAS float*)(lds + C2_GC);
    LAS bf16_t* wsm = (LAS bf16_t*)(lds + C2_W); LAS bf16_t* uT = (LAS bf16_t*)(lds + C2_UT); LAS bf16_t* ks = (LAS bf16_t*)(lds + C2_KS); LAS bf16_t* vT = (LAS bf16_t*)(lds + C2_VT);
    LAS bf16_t* Tp = (LAS bf16_t*)(lds + C2_TP); LAS bf16_t* Tpp = (LAS bf16_t*)(lds + C2_TPP); LAS bf16_t* oL = (LAS bf16_t*)(lds + C2_OL); LAS bf16_t* qL = (LAS bf16_t*)(lds + C2_QL); LAS float* fac = (LAS float*)(lds + C2_FAC);
    const int r32 = lane & 31, hi = lane >> 5, pw = wave - 1;
    const float scale = 0.08838834764831845f;
#define LBAR() do { asm volatile("s_waitcnt lgkmcnt(0)" ::: "memory"); __builtin_amdgcn_s_barrier(); asm volatile("" ::: "memory"); } while (0)
    if ((int)blockIdx.x < 256) {
    const int wi = blockIdx.x, w = (wi & 7) * 32 + (wi >> 3);
    const int b = w >> 6, h = (w >> 3) & 7, dir = (w >> 2) & 1, dvq = w & 3;
    bf16_t* Od = dir ? (bf16_t*)a.out + (size_t)ML * 1024 : (bf16_t*)(ws + WS_OF);
#define C2_UNIT(s_, u_, rb_, lat_) do { if ((s_) < 4) { const int cc_ = dir ? 3 - (s_) : (s_); u_ = 4096 + (b * 8 + h) * 4 + cc_; rb_ = ML + b * CTXL + cc_ * 64; lat_ = false; } \
        else { const int cc_ = dir ? 131 - (s_) : (s_) - 4; u_ = (b * 8 + h) * 128 + cc_; rb_ = b * SEQ + cc_ * 64; lat_ = true; } } while (0)
    u32x4 xq0, xq1, xq2, xk0, xk1, xk2, xv0, xt0, xt1; f32x4 xg0, xg1, xb0, xb1; float pgc;
#define C2_LOAD(s_) do { int u_, rb_; bool lat_; C2_UNIT(s_, u_, rb_, lat_); \
        const bf16_t* Tg_ = (lat_ ? TL + (size_t)u_ * 8192 : TC + (size_t)(u_ - 4096) * 8192) + dir * 4096; \
        const float* gcu_ = GCU + ((size_t)u_ * 2 + dir) * 64; const float* btu_ = BTU + ((size_t)u_ * 2 + dir) * 64; const float* beu_ = BEU + ((size_t)u_ * 2 + dir) * 64; \
        const bf16_t* QRs_ = lat_ ? QR : (const bf16_t*)(ws + WS_QCX) - (size_t)ML * 1024; const size_t st_ = lat_ ? QKV_STRIDE : CTX_STRIDE; \
        { const int ptid_ = tid - 64; const bf16_t* qb_ = QRs_ + (size_t)rb_ * 1024 + h * 128; \
          _Pragma("unroll") for (int m_ = 0; m_ < 3; ++m_) { const int p_ = ptid_ + 448 * m_, t_ = (p_ >> 4) & 63, c_ = p_ & 15; const u32x4 v_ = *(const u32x4*)(qb_ + (size_t)(dir ? 63 - t_ : t_) * 1024 + c_ * 8); if (m_ == 0) xq0 = v_; else if (m_ == 1) xq1 = v_; else xq2 = v_; } \
          xt0 = *(const u32x4*)(Tg_ + ptid_ * 8); xt1 = *(const u32x4*)(Tg_ + (448 + lane) * 8); \
          xg0 = *(const f32x4*)(beu_ + (lane & 7) * 8); xg1 = *(const f32x4*)(beu_ + (lane & 7) * 8 + 4); xb0 = *(const f32x4*)(btu_ + (lane & 7) * 8); xb1 = *(const f32x4*)(btu_ + (lane & 7) * 8 + 4); } \
        { const bf16_t* kb_ = QRs_ + st_ + (size_t)rb_ * 1024 + h * 128; const bf16_t* vb_ = QRs_ + 2 * st_ + (size_t)rb_ * 1024 + h * 128 + dvq * 32; \
          _Pragma("unroll") for (int m_ = 0; m_ < 3; ++m_) { const int blk_ = (pw + 7 * m_) & 15, t_ = (blk_ & 3) * 16 + (lane & 15), c_ = (blk_ >> 2) * 4 + (lane >> 4); \
              const u32x4 v_ = *(const u32x4*)(kb_ + (size_t)(dir ? 63 - t_ : t_) * 1024 + c_ * 8); if (m_ == 0) xk0 = v_; else if (m_ == 1) xk1 = v_; else xk2 = v_; } \
          { const int t_ = (pw & 3) * 16 + (lane & 15), c_ = lane >> 4; xv0 = *(const u32x4*)(vb_ + (size_t)(dir ? 63 - t_ : t_) * 1024 + c_ * 8); } } \
        pgc = gcu_[lane]; } while (0)
#ifdef EXP_DUPK
#define C2_DUPK(d, v) do { asm volatile("" ::: "memory"); C2_TR8(d, v); asm volatile("" ::: "memory"); } while (0)
#else
#define C2_DUPK(d, v) do {} while (0)
#endif
#define C2_TR8(dst_, v_) do { LAS bf16_t* d_ = (dst_); d_[0 * 72] = (bf16_t)((v_).x & 0xffffu); d_[1 * 72] = (bf16_t)((v_).x >> 16); d_[2 * 72] = (bf16_t)((v_).y & 0xffffu); d_[3 * 72] = (bf16_t)((v_).y >> 16); \
        d_[4 * 72] = (bf16_t)((v_).z & 0xffffu); d_[5 * 72] = (bf16_t)((v_).z >> 16); d_[6 * 72] = (bf16_t)((v_).w & 0xffffu); d_[7 * 72] = (bf16_t)((v_).w >> 16); } while (0)
#define C2_TPIECE(p_, tv_) do { const int i_ = (p_) >> 3, c8_ = (p_) & 7; float tf_[8], f1_[8], f2_[8]; unpack8(tv_, tf_); \
        const float gg_[8] = {xg0.x, xg0.y, xg0.z, xg0.w, xg1.x, xg1.y, xg1.z, xg1.w}, bb_[8] = {xb0.x, xb0.y, xb0.z, xb0.w, xb1.x, xb1.y, xb1.z, xb1.w}; \
        _Pragma("unroll") for (int e_ = 0; e_ < 8; ++e_) { f2_[e_] = tf_[e_] * bb_[e_]; f1_[e_] = tf_[e_] * gg_[e_]; } \
        *(LAS u32x4*)(Tp + i_ * 72 + c8_ * 8) = pack8f(f1_); *(LAS u32x4*)(Tpp + i_ * 72 + c8_ * 8) = pack8f(f2_); } while (0)
#define C2_STAGE_A(nb_) do { LAS bf16_t* qsn_ = qs + (nb_) * 8704; LAS bf16_t* kTn_ = kT + (nb_) * 9216; const int ptid_ = tid - 64; \
        { const int p0_ = ptid_, p1_ = ptid_ + 448, p2_ = ptid_ + 896; \
          *(LAS u32x4*)(qsn_ + (p0_ >> 4) * 136 + (p0_ & 15) * 8) = xq0; *(LAS u32x4*)(qsn_ + (p1_ >> 4) * 136 + (p1_ & 15) * 8) = xq1; if (p2_ < 1024) *(LAS u32x4*)(qsn_ + (p2_ >> 4) * 136 + (p2_ & 15) * 8) = xq2; } \
        { const int b0_ = pw, b1_ = pw + 7, b2_ = pw + 14, tl_ = lane & 15, cl_ = lane >> 4; \
          { const int t_ = (b0_ & 3) * 16 + tl_, c_ = (b0_ >> 2) * 4 + cl_; *(LAS u32x4*)(ks + t_ * 136 + c_ * 8) = xk0; C2_TR8(kTn_ + (c_ * 8) * 72 + t_, xk0); C2_DUPK(kTn_ + (c_ * 8) * 72 + t_, xk0); } \
          { const int t_ = (b1_ & 3) * 16 + tl_, c_ = (b1_ >> 2) * 4 + cl_; *(LAS u32x4*)(ks + t_ * 136 + c_ * 8) = xk1; C2_TR8(kTn_ + (c_ * 8) * 72 + t_, xk1); C2_DUPK(kTn_ + (c_ * 8) * 72 + t_, xk1); } \
          if (b2_ < 16) { const int t_ = (b2_ & 3) * 16 + tl_, c_ = (b2_ >> 2) * 4 + cl_; *(LAS u32x4*)(ks + t_ * 136 + c_ * 8) = xk2; C2_TR8(kTn_ + (c_ * 8) * 72 + t_, xk2); } \
          if (pw < 4) { const int t_ = pw * 16 + tl_; C2_TR8(vT + (cl_ * 8) * 72 + t_, xv0); } } \
        C2_TPIECE(ptid_, xt0); if (pw == 6) C2_TPIECE(448 + lane, xt1); \
        if (pw == 1) { gcs[(nb_) * 64 + lane] = pgc; const float g63_ = __shfl(pgc, 63); fac[(nb_) * 128 + lane] = scale * __expf(pgc); fac[(nb_) * 128 + 64 + lane] = __expf(g63_ - pgc); } } while (0)
#define C2_WJOB(jw_) do { const int dkt_ = (jw_) >> 1, it_ = (jw_) & 1; f32x16 acc_ = {}; bf16x8 fa_[4], fb_[4]; \
        _Pragma("unroll") for (int kk = 0; kk < 4; ++kk) { fa_[kk] = *(const LAS bf16x8*)(kTn + (dkt_ * 32 + r32) * 72 + kk * 16 + hi * 8); fb_[kk] = *(const LAS bf16x8*)(Tp + (it_ * 32 + r32) * 72 + kk * 16 + hi * 8); } \
        _Pragma("unroll") for (int kk = 0; kk < 4; ++kk) acc_ = MFMA32(fa_[kk], fb_[kk], acc_); \
        _Pragma("unroll") for (int g = 0; g < 4; ++g) st4(wsm + (it_ * 32 + r32) * 136 + dkt_ * 32 + 8 * g + 4 * hi, acc_[4 * g], acc_[4 * g + 1], acc_[4 * g + 2], acc_[4 * g + 3]); } while (0)
#define C2_UJOB(it_) do { f32x16 acc_ = {}; bf16x8 fa_[4], fb_[4]; \
        _Pragma("unroll") for (int kk = 0; kk < 4; ++kk) { fa_[kk] = *(const LAS bf16x8*)(Tpp + ((it_) * 32 + r32) * 72 + kk * 16 + hi * 8); fb_[kk] = *(const LAS bf16x8*)(vT + r32 * 72 + kk * 16 + hi * 8); } \
        _Pragma("unroll") for (int kk = 0; kk < 4; ++kk) acc_ = MFMA32(fa_[kk], fb_[kk], acc_); \
        _Pragma("unroll") for (int g = 0; g < 4; ++g) st4(uT + r32 * 72 + (it_) * 32 + 8 * g + 4 * hi, acc_[4 * g], acc_[4 * g + 1], acc_[4 * g + 2], acc_[4 * g + 3]); } while (0)
#define C2_QKJOB(it_, jt_) do { f32x16 acc_ = {}; \
        _Pragma("unroll") for (int kh = 0; kh < 2; ++kh) { bf16x8 fa_[4], fb_[4]; \
            _Pragma("unroll") for (int k4 = 0; k4 < 4; ++k4) { const int kk = kh * 4 + k4; fa_[k4] = *(const LAS bf16x8*)(ks + ((jt_) * 32 + r32) * 136 + kk * 16 + hi * 8); fb_[k4] = *(const LAS bf16x8*)(qsn + ((it_) * 32 + r32) * 136 + kk * 16 + hi * 8); } \
            _Pragma("unroll") for (int k4 = 0; k4 < 4; ++k4) acc_ = MFMA32(fa_[k4], fb_[k4], acc_); } \
        const int i_ = (it_) * 32 + r32; const float gi_ = gcn[i_]; \
        _Pragma("unroll") for (int g = 0; g < 4; ++g) { const int jb_ = (jt_) * 32 + 8 * g + 4 * hi; const f32x4 gj_ = *(const LAS f32x4*)(gcn + jb_); \
            const float v0_ = (jb_ + 0 <= i_) ? acc_[4 * g + 0] * scale * __expf(fminf(gi_ - gj_.x, 0.f)) : 0.f, v1_ = (jb_ + 1 <= i_) ? acc_[4 * g + 1] * scale * __expf(fminf(gi_ - gj_.y, 0.f)) : 0.f; \
            const float v2_ = (jb_ + 2 <= i_) ? acc_[4 * g + 2] * scale * __expf(fminf(gi_ - gj_.z, 0.f)) : 0.f, v3_ = (jb_ + 3 <= i_) ? acc_[4 * g + 3] * scale * __expf(fminf(gi_ - gj_.w, 0.f)) : 0.f; \
            st4(qkn + i_ * 72 + jb_, v0_, v1_, v2_, v3_); } } while (0)
#define C2_STAGE_B(nb_) do { const LAS bf16_t* qsn = qs + (nb_) * 8704; const LAS bf16_t* kTn = kT + (nb_) * 9216; LAS bf16_t* qkn = qk + (nb_) * 4608; const LAS float* gcn = gcs + (nb_) * 64; \
        if (pw == 0) { C2_QKJOB(0, 0); C2_UJOB(0); } else if (pw == 1) C2_QKJOB(1, 0); else if (pw == 2) C2_QKJOB(1, 1); \
        else if (pw == 3) { C2_UJOB(1); C2_WJOB(0); C2_WJOB(1); } else if (pw == 4) { C2_WJOB(2); C2_WJOB(3); } \
        else if (pw == 5) { C2_WJOB(4); C2_WJOB(5); } else { C2_WJOB(6); C2_WJOB(7); } } while (0)
#define C2_OSTORE(sprev_) do { int u_, rb_; bool lat_; C2_UNIT(sprev_, u_, rb_, lat_); (void)u_; \
        if (lat_ && pw < 4) { unsigned o_[8]; _Pragma("unroll") for (int e_ = 0; e_ < 8; ++e_) o_[e_] = oL[((sprev_) & 1) * 2304 + (pw * 8 + e_) * 72 + lane]; \
            u32x4 ow_; ow_.x = o_[0] | (o_[1] << 16); ow_.y = o_[2] | (o_[3] << 16); ow_.z = o_[4] | (o_[5] << 16); ow_.w = o_[6] | (o_[7] << 16); \
            *(u32x4*)(Od + ((size_t)rb_ + (dir ? 63 - lane : lane)) * 1024 + h * 128 + dvq * 32 + pw * 8) = ow_; } } while (0)
    if (wave == 0) {
    f32x16 S0 = {}, S1 = {}, S2 = {}, S3 = {};
    LBAR();
    LBAR();
#pragma unroll 1
    for (int s = 0; s < 132; ++s) {
        const int p = s & 1;
        int l136 = r32 * 136 + 4 * hi, l72 = r32 * 72 + 4 * hi, h4 = 4 * hi; asm volatile("" : "+v"(l136), "+v"(l72), "+v"(h4));
        const LAS bf16_t* qsp = qs + p * 8704 + l136; const LAS bf16_t* kTp = kT + p * 9216 + l72; const LAS bf16_t* qkp = qk + p * 4608 + l72; const LAS float* gcp = gcs + p * 64 + h4; const LAS float* gcp0 = gcs + p * 64; const LAS float* f1p = fac + p * 128 + h4; const LAS float* f2p = f1p + 64;
        const LAS bf16_t* wsl = wsm + l136; const LAS bf16_t* uTl = uT + l72; LAS bf16_t* oLl = oL + p * 2304 + l72;
        f32x16 vn0, vn1; bf16x8 vc00, vc01, vc10, vc11;
#ifdef EXP_SLEEP_C1
        __builtin_amdgcn_s_sleep(16);
#endif
        {
            const bf16x8 sb00 = PACKFRAG(S0, 0), sb01 = PACKFRAG(S0, 1), sb10 = PACKFRAG(S1, 0), sb11 = PACKFRAG(S1, 1), sb20 = PACKFRAG(S2, 0), sb21 = PACKFRAG(S2, 1), sb30 = PACKFRAG(S3, 0), sb31 = PACKFRAG(S3, 1);
#define C2_SDOT(acc_, base_) do { const LAS bf16_t* b_ = (base_); \
            acc_ = MFMA32(rdfrag(b_ + 0), sb00, acc_); acc_ = MFMA32(rdfrag(b_ + 16), sb01, acc_); acc_ = MFMA32(rdfrag(b_ + 32), sb10, acc_); acc_ = MFMA32(rdfrag(b_ + 48), sb11, acc_); \
            acc_ = MFMA32(rdfrag(b_ + 64), sb20, acc_); acc_ = MFMA32(rdfrag(b_ + 80), sb21, acc_); acc_ = MFMA32(rdfrag(b_ + 96), sb30, acc_); acc_ = MFMA32(rdfrag(b_ + 112), sb31, acc_); } while (0)
            { f32x16 acc = {}; C2_SDOT(acc, wsl);
#pragma unroll
              for (int g = 0; g < 4; ++g) { const u32x2 uu = *(const LAS u32x2*)(uTl + 0 * 32 + 8 * g);
                  vn0[4 * g + 0] = bflo(uu.x) - acc[4 * g + 0]; vn0[4 * g + 1] = bfhi(uu.x) - acc[4 * g + 1]; vn0[4 * g + 2] = bflo(uu.y) - acc[4 * g + 2]; vn0[4 * g + 3] = bfhi(uu.y) - acc[4 * g + 3]; } }
            { f32x16 acc = {}; C2_SDOT(acc, wsl + 32 * 136);
#pragma unroll
              for (int g = 0; g < 4; ++g) { const u32x2 uu = *(const LAS u32x2*)(uTl + 1 * 32 + 8 * g);
                  vn1[4 * g + 0] = bflo(uu.x) - acc[4 * g + 0]; vn1[4 * g + 1] = bfhi(uu.x) - acc[4 * g + 1]; vn1[4 * g + 2] = bflo(uu.y) - acc[4 * g + 2]; vn1[4 * g + 3] = bfhi(uu.y) - acc[4 * g + 3]; } }
            f32x16 qa = {}, qb = {};
            C2_SDOT(qa, qsp); C2_SDOT(qb, qsp + 32 * 136);
#pragma unroll
            for (int g = 0; g < 4; ++g) { const f32x4 ga = *(const LAS f32x4*)(f1p + 0 * 32 + 8 * g), gb = *(const LAS f32x4*)(f1p + 1 * 32 + 8 * g);
                qa[4 * g + 0] *= ga.x; qa[4 * g + 1] *= ga.y; qa[4 * g + 2] *= ga.z; qa[4 * g + 3] *= ga.w;
                qb[4 * g + 0] *= gb.x; qb[4 * g + 1] *= gb.y; qb[4 * g + 2] *= gb.z; qb[4 * g + 3] *= gb.w; }
            __builtin_amdgcn_sched_barrier(0);
            { const bf16x8 vb00 = PACKFRAG(vn0, 0), vb01 = PACKFRAG(vn0, 1), vb10 = PACKFRAG(vn1, 0), vb11 = PACKFRAG(vn1, 1);
              qa = MFMA32(rdfrag(qkp + 0), vb00, qa); qa = MFMA32(rdfrag(qkp + 16), vb01, qa);
              const LAS bf16_t* b_ = qkp + 32 * 72;
              qb = MFMA32(rdfrag(b_ + 0), vb00, qb); qb = MFMA32(rdfrag(b_ + 16), vb01, qb); qb = MFMA32(rdfrag(b_ + 32), vb10, qb); qb = MFMA32(rdfrag(b_ + 48), vb11, qb);
#pragma unroll
              for (int g = 0; g < 4; ++g) { st4(oLl + 0 * 32 + 8 * g, qa[4 * g], qa[4 * g + 1], qa[4 * g + 2], qa[4 * g + 3]); st4(oLl + 1 * 32 + 8 * g, qb[4 * g], qb[4 * g + 1], qb[4 * g + 2], qb[4 * g + 3]); } }
            __builtin_amdgcn_sched_barrier(0);
#pragma unroll
            for (int g = 0; g < 4; ++g) { const f32x4 ga = *(const LAS f32x4*)(f2p + 0 * 32 + 8 * g), gb = *(const LAS f32x4*)(f2p + 1 * 32 + 8 * g);
                vn0[4 * g + 0] *= ga.x; vn0[4 * g + 1] *= ga.y; vn0[4 * g + 2] *= ga.z; vn0[4 * g + 3] *= ga.w;
                vn1[4 * g + 0] *= gb.x; vn1[4 * g + 1] *= gb.y; vn1[4 * g + 2] *= gb.z; vn1[4 * g + 3] *= gb.w; }
            vc00 = PACKFRAG(vn0, 0); vc01 = PACKFRAG(vn0, 1); vc10 = PACKFRAG(vn1, 0); vc11 = PACKFRAG(vn1, 1);
#undef C2_SDOT
        }
        LBAR();
        {
#ifdef EXP_SLEEP_C2
            __builtin_amdgcn_s_sleep(16);
#endif
            const float gl = __expf(gcp0[63]);
            { bf16x8 ka[4][4];
#pragma unroll
              for (int t = 0; t < 4; ++t)
#pragma unroll
                for (int q = 0; q < 4; ++q) ka[t][q] = rdfrag(kTp + t * 32 * 72 + q * 16);
#pragma unroll
              for (int r = 0; r < 16; ++r) { S0[r] *= gl; S1[r] *= gl; S2[r] *= gl; S3[r] *= gl; }
              S0 = MFMA32(ka[0][0], vc00, S0); S1 = MFMA32(ka[1][0], vc00, S1); S2 = MFMA32(ka[2][0], vc00, S2); S3 = MFMA32(ka[3][0], vc00, S3);
              S0 = MFMA32(ka[0][1], vc01, S0); S1 = MFMA32(ka[1][1], vc01, S1); S2 = MFMA32(ka[2][1], vc01, S2); S3 = MFMA32(ka[3][1], vc01, S3);
              S0 = MFMA32(ka[0][2], vc10, S0); S1 = MFMA32(ka[1][2], vc10, S1); S2 = MFMA32(ka[2][2], vc10, S2); S3 = MFMA32(ka[3][2], vc10, S3);
              S0 = MFMA32(ka[0][3], vc11, S0); S1 = MFMA32(ka[1][3], vc11, S1); S2 = MFMA32(ka[2][3], vc11, S2); S3 = MFMA32(ka[3][3], vc11, S3); }
        }
        LBAR();
    }
    LBAR();
    } else {
    C2_LOAD(0); C2_STAGE_A(0);
    LBAR();
    C2_LOAD(1); C2_STAGE_B(0);
    LBAR();
#pragma unroll 1
    for (int s = 0; s < 132; ++s) {
        const int np = (s & 1) ^ 1;
#ifdef EXP_SLEEP_P1
        __builtin_amdgcn_s_sleep(16);
#endif
        if (s + 1 < 132) C2_STAGE_A(np);
        if (s > 0) C2_OSTORE(s - 1);
        if (s + 2 < 132) C2_LOAD(s + 2);
        LBAR();
        if (s + 1 < 132) C2_STAGE_B(np);
        LBAR();
    }
    C2_OSTORE(131);
    LBAR();
    }
    }
#undef LBAR
#undef C2_UNIT
#undef C2_LOAD
#undef C2_TR8
#undef C2_TPIECE
#undef C2_STAGE_A
#undef C2_WJOB
#undef C2_UJOB
#undef C2_QKJOB
#undef C2_STAGE_B
#undef C2_OSTORE
}
#define GAS __attribute__((address_space(1)))
#define XB_TMO      128
#define XB_XCNT(j)  (256  + 64 * (j))
#define XB_XSUB(j)  (1280 + 64 * (j))
#define XB_XGEN(j)  (2304 + 64 * (j))
#define XB_TOP      3328
#define XB_TOPGEN   3392
#define XCD_BAR_WORDS 3456
#define XB_SPIN_CAP (1u << 18)
#ifndef XB_SLEEP
#define XB_SLEEP 1
#endif

__device__ __forceinline__ unsigned xb_ld(unsigned* p)              { return __hip_atomic_load(p, __ATOMIC_RELAXED, __HIP_MEMORY_SCOPE_AGENT); }
__device__ __forceinline__ unsigned xb_add(unsigned* p, unsigned v) { return __hip_atomic_fetch_add(p, v, __ATOMIC_RELAXED, __HIP_MEMORY_SCOPE_AGENT); }
__device__ __forceinline__ unsigned xb_xcc_id() { return (unsigned)__builtin_amdgcn_s_getreg((3 << 11) | 20) & 0xFu; }
#define XB_SPIN(cond, bar) do { unsigned _sp = 0; while (cond) { __builtin_amdgcn_s_sleep(XB_SLEEP); \
    if ((++_sp & 255u) == 0u) { if (xb_ld(&(bar)[XB_TMO])) break; if (_sp > XB_SPIN_CAP) { atomicAdd(&(bar)[XB_TMO], 1u); break; } } } } while (0)

struct XcdBarrier {
    unsigned* bar; unsigned x;
    volatile LAS unsigned* st;
};

__device__ __forceinline__ XcdBarrier xcd_barrier_post(unsigned* bar, volatile LAS unsigned* st) {
    XcdBarrier b; b.bar = bar; b.x = xb_xcc_id(); b.st = st;
    if (threadIdx.x == 0) (void)xb_add(&bar[XB_XCNT(b.x)], 1u);
    return b;
}
__device__ __forceinline__ void xcd_barrier_complete(unsigned* bar, unsigned x, unsigned& nloc, unsigned& nx) {
    const unsigned G = gridDim.x * gridDim.y * gridDim.z;
    unsigned sum, cnt, mine, sp = 0u;
    for (;;) {
        sum = 0u; cnt = 0u; mine = 0u;
#pragma unroll
        for (unsigned j = 0; j < 16; ++j) { const unsigned c = xb_ld(&bar[XB_XCNT(j)]); sum += c; cnt += (c > 0u) ? 1u : 0u; mine = (j == x) ? c : mine; }
        if (sum == G) break;
        __builtin_amdgcn_s_sleep(XB_SLEEP);
        if ((++sp & 255u) == 0u) { if (xb_ld(&bar[XB_TMO])) break; if (sp > XB_SPIN_CAP) { atomicAdd(&bar[XB_TMO], 1u); break; } }
    }
    nloc = mine > 0u ? mine : 1u; nx = cnt > 0u ? cnt : 1u;
}

__device__ __forceinline__ void xcd_barrier(const XcdBarrier& b) {
    asm volatile("s_waitcnt vmcnt(0)" ::: "memory");
    __syncthreads();
    if (threadIdx.x == 0) {
        unsigned* bar = b.bar;
        __builtin_amdgcn_s_waitcnt(0);
        unsigned nloc = b.st[0], nx = b.st[1];
        if (nloc == 0u) { xcd_barrier_complete(bar, b.x, nloc, nx); b.st[0] = nloc; b.st[1] = nx; }
        const unsigned old = xb_add(&bar[XB_XSUB(b.x)], 1u);
        const unsigned gen = old / nloc;
        if (old + 1u == (gen + 1u) * nloc) {
            __builtin_amdgcn_fence(__ATOMIC_RELEASE, "agent");
            asm volatile("s_waitcnt vmcnt(0)" ::: "memory");
            const unsigned og = xb_add(&bar[XB_TOP], 1u);
            const unsigned tg = og / nx;
            if (og + 1u == (tg + 1u) * nx) xb_add(&bar[XB_TOPGEN], 1u);
            else XB_SPIN(xb_ld(&bar[XB_TOPGEN]) == tg, bar);
            __builtin_amdgcn_fence(__ATOMIC_ACQUIRE, "agent");
            xb_add(&bar[XB_XGEN(b.x)], 1u);
            asm volatile("s_waitcnt vmcnt(0)" ::: "memory");
        } else {
            XB_SPIN(xb_ld(&bar[XB_XGEN(b.x)]) == gen, bar);
            __builtin_amdgcn_fence(__ATOMIC_ACQUIRE, "agent");
            asm volatile("s_waitcnt vmcnt(0)" ::: "memory");
        }
    }
    __syncthreads();
}

constexpr int N_PHASES = 19;
#ifndef CHAIN_FN
#define CHAIN_FN gdn_chain2
#endif
#ifndef REP_ATT
#define REP_ATT 1
#endif
#ifndef REP_CHAIN
#define REP_CHAIN 1
#endif
#ifndef REP_SMALL
#define REP_SMALL 0
#endif
#ifndef REP_PREP
#define REP_PREP 0
#endif
#ifndef REP_GEMM
#define REP_GEMM 1
#endif
#ifndef MK_PER_PHASE
#define MK_PER_PHASE 0
#endif
struct PassASched { int G, c;
    __device__ __forceinline__ bool next(int i, pg8::Unit& u) const {
        if (G == 256) {
            const int x = c & 7, q = (c >> 3) + 32 * i, np = (x < 4) ? 17 : 16;
            if (q < 3 * np) { u.pm = x + 8 * (q / 3); u.pn = 24 + q % 3; return true; }
            const int r = q - 3 * np; if (r < 6) { const int e = x * 6 + r; u.pm = 128 + (e & 3); u.pn = e >> 2; return true; }
            return false; }
        const int L = i * G + c;
        if (L < 396) { u.pm = L % 132; u.pn = 24 + L / 132; return true; }
        if (L < 444) { const int L2 = L - 396; u.pm = 128 + (L2 & 3); u.pn = L2 >> 2; return true; }
        return false; }
    __device__ __forceinline__ void a_ready(const pg8::Unit&) const {}
    __device__ __forceinline__ void done(const pg8::Unit&) const {} };
template <class Op> __device__ __forceinline__ void run_gemm(LAS unsigned char* lds, const bf16_t* A, const bf16_t* Bt, int M, int N, int K, const Op& op) {
    pg8::Gemm g{A, Bt, M, N, K}; pg8::StaticOrder S; S.init(M, N, (int)gridDim.x, (int)blockIdx.x);
    pg8::EpiOp<Op> E{op};
    pg8::gemm_phase<pg8::EpiOp<Op>, pg8::StaticOrder, true, true>(lds, g, S, E);
}
__global__ void __launch_bounds__(NTHR, 2) fwd_kernel(Args a) {
    extern __shared__ __attribute__((aligned(16))) unsigned char lds_[];
    LAS unsigned char* lds = (LAS unsigned char*)lds_;
    cg::grid_group grid = cg::this_grid();
    const int tid = threadIdx.x, lane = tid & 63, wave = __builtin_amdgcn_readfirstlane(tid >> 6);
    const int lo = a.ph_lo, hi = a.ph_hi;
    volatile LAS unsigned* bst = (volatile LAS unsigned*)(lds + LDS_BYTES - 64);
    if (tid < 2) bst[tid] = 0u;
    __syncthreads();
    XcdBarrier xbar = xcd_barrier_post((unsigned*)(a.ws + WS_CTL) + CW_BAR, bst);
    unsigned char* ws = a.ws;
    const float* x = a.in[0]; const float* ctx = a.in[2]; float* out = a.out;
    float* MOD = (float*)(ws + WS_MOD);
    bf16_t* WIN = (bf16_t*)(ws + WS_WIN); bf16_t* H = (bf16_t*)(ws + WS_H);
#ifndef PH_MASK
#define PH_MASK 0x7ffff
#endif
#define IN(k) ((((PH_MASK) >> (k)) & 1) && lo <= (k) && (k) < hi)
#define SEAM(k) do { if (IN(k) && IN((k) + 1)) xcd_barrier(xbar); } while (0)
#ifdef REP_SYNC
    for (int i_ = 0; i_ < REP_SYNC; ++i_) grid.sync();
#endif
    if (hi > 1000) grid.sync();
    if (IN(0)) { if (REP_SMALL) { p0_prologue(a, lds, tid, lane, wave); __syncthreads(); } p0_prologue(a, lds, tid, lane, wave); }
    SEAM(0);
#ifdef REP_XSYNC
    for (int i_ = 0; i_ < REP_XSYNC; ++i_) xcd_barrier(xbar);
#endif
    if (IN(1)) { if (REP_SMALL) rms_mod_rows(x, ctx, MT, a.in[6], MOD, 0, 1, H, lane, wave); rms_mod_rows(x, ctx, MT, a.in[6], MOD, 0, 1, H, lane, wave); }
    SEAM(1);
    if (IN(2)) { pg8::OpRouteA ra{(bf16_t*)(ws + WS_CQ), (bf16_t*)(ws + WS_CKV), (bf16_t*)(ws + WS_KR), (float*)(ws + WS_BD)};
        pg8::OpPassA2 op{ra, (bf16_t*)(ws + WS_QCX), CTX_STRIDE, (bf16_t*)(ws + WS_HALO), ML};
        pg8::Gemm g{H, WIN, MT, 6912, 1024}; PassASched S{(int)gridDim.x, (int)blockIdx.x}; pg8::EpiOp<pg8::OpPassA2> E{op};
        pg8::gemm_phase<pg8::EpiOp<pg8::OpPassA2>, PassASched, true, true>(lds, g, S, E); }
    SEAM(2);
    if (IN(3)) { if (REP_SMALL) mla_prenorm(a, lane, wave, true); mla_prenorm(a, lane, wave, false); }
    SEAM(3);
    if (IN(4)) { { pg8::OpPlain op{(bf16_t*)out, 1536}; run_gemm(lds, (const bf16_t*)(ws + WS_CQ), (const bf16_t*)(ws + WS_WUQ), ML, 1536, 384, op); }
                 { pg8::OpPlain op{(bf16_t*)(ws + WS_KVRAW), 2048}; run_gemm(lds, (const bf16_t*)(ws + WS_CKV), (const bf16_t*)(ws + WS_WUKV), MT, 2048, 256, op); } }
    SEAM(4);
    if (IN(5)) { if (REP_SMALL) mla_finish(a, lane, wave, true); mla_finish(a, lane, wave, false); }
    SEAM(5);
    if (IN(6)) {
        const att::bf16* Q = (const att::bf16*)out; const att::bf16* KF = (const att::bf16*)(ws + WS_KF); const att::bf16* KV = (const att::bf16*)(ws + WS_KVRAW); att::bf16* O = (att::bf16*)(ws + WS_O);
        const int G = gridDim.x, bx = blockIdx.x, vcu = (G % 8 == 0) ? (bx % 8) * (G / 8) + bx / 8 : bx;
        for (int rep = 0; rep < REP_ATT; ++rep)
        for (int n = vcu; n < 1024; n += G) {
            const int bh = ((n & 255) >> 5) * 4 + (n >> 8), qb = n & 31, b = bh >> 3, h = bh & 7;
            att::attn_dense_body<ATT_SDEPTH>(Q + ((size_t)b * SEQ + qb * 256) * 1536 + h * 192,
                KF + ((size_t)ML + b * CTXL) * 1536 + h * 192, KF + ((size_t)b * SEQ) * 1536 + h * 192,
                KV + ((size_t)ML + b * CTXL) * 2048 + h * 256 + 128, KV + ((size_t)b * SEQ) * 2048 + h * 256 + 128,
                O + ((size_t)b * SEQ + qb * 256) * 1024 + h * 128, CTXL + SEQ, (char*)lds_);
        }
    }
    SEAM(6);
#ifndef REP_GDNPRE
#define REP_GDNPRE 1
#endif
    for (int rep_ = 0; rep_ < REP_GDNPRE; ++rep_) {
    if (rep_ > 0) grid.sync();
    if (IN(7)) { pg8::OpSplit3 op{(bf16_t*)(ws + WS_QR), QKV_STRIDE, (bf16_t*)(ws + WS_HALO)}; run_gemm(lds, H, WIN, ML, 3072, 1024, op); }
    SEAM(7);
    if (IN(9)) { if (REP_PREP) { gdn_prep(a, lds, tid, lane, wave, true); __syncthreads(); } gdn_prep(a, lds, tid, lane, wave, false); }
    SEAM(9);
    }
    if (IN(10)) for (int rep = 0; rep < REP_CHAIN; ++rep) { if (gridDim.x >= 256) gdn_chain2(a, lds, tid, lane, wave); else gdn_chain(a, lds, tid, lane, wave); __syncthreads(); }
    SEAM(10);
    if (IN(11)) { pg8::OpZGate op{(bf16_t*)(ws + WS_Z), (bf16_t*)(ws + WS_SG)}; run_gemm(lds, H, WIN + (size_t)3072 * 1024, ML, 3072, 1024, op); }
    SEAM(11);
    if (IN(12)) { if (REP_SMALL) gdn_combine(a, tid, true); gdn_combine(a, tid, false); }
    SEAM(12);
    if (IN(13)) { pg8::OpGate<false> op{(bf16_t*)(ws + WS_Y), (const bf16_t*)(ws + WS_SG), 0}; run_gemm(lds, (const bf16_t*)(ws + WS_OF), (const bf16_t*)(ws + WS_WBG), ML, 1024, 1024, op); }
    if (IN(14)) { pg8::OpGate<true> op{(bf16_t*)(ws + WS_Y), (const bf16_t*)(ws + WS_SG), 1024}; run_gemm(lds, (const bf16_t*)(ws + WS_O), (const bf16_t*)(ws + WS_WBM), ML, 1024, 1024, op); }
    SEAM(14);
    if (IN(15)) { pg8::OpResid op{x, out, MOD + 2 * 1024}; run_gemm(lds, (const bf16_t*)(ws + WS_Y), (const bf16_t*)(ws + WS_WOUT), ML, 1024, 1024, op); }
    SEAM(15);
    if (IN(16)) { if (REP_SMALL) rms_mod_rows(out, out, ML, a.in[7], MOD, 3, 4, H, lane, wave); rms_mod_rows(out, out, ML, a.in[7], MOD, 3, 4, H, lane, wave); }
    SEAM(16);
    if (IN(17)) { pg8::OpRelu2 op{(bf16_t*)(ws + WS_HID)}; run_gemm(lds, H, (const bf16_t*)(ws + WS_WM1), ML, 4096, 1024, op);
#ifdef REP_P17
        __syncthreads(); run_gemm(lds, H, (const bf16_t*)(ws + WS_WM1), ML, 4096, 1024, op);
#endif
    }
    SEAM(17);
    if (IN(18)) { pg8::OpResid op{out, out, MOD + 5 * 1024}; run_gemm(lds, (const bf16_t*)(ws + WS_HID), (const bf16_t*)(ws + WS_WM2), ML, 1024, 4096, op); }
#undef IN
#undef SEAM
}

extern "C" void kernel_launch(void* const* d_in, const int* in_sizes, int n_in, void* d_out, int out_size, void* d_ws, size_t ws_size, hipStream_t stream) {
    static int grid = 0;
    if (grid == 0) {
        if (n_in != 24 || in_sizes[0] != ML * DM || out_size != ML * DM || ws_size < WS_END) { fprintf(stderr, "kernel_launch: unexpected shapes (n_in %d, in0 %d, out %d, ws %zu)\n", n_in, n_in > 0 ? in_sizes[0] : -1, out_size, ws_size); grid = -1; return; }
        int dev = 0, cus = 0, per_cu = 0;
        if (hipGetDevice(&dev) != hipSuccess || hipDeviceGetAttribute(&cus, hipDeviceAttributeMultiprocessorCount, dev) != hipSuccess) { grid = -1; return; }
        if (hipFuncSetAttribute((const void*)fwd_kernel, hipFuncAttributeMaxDynamicSharedMemorySize, LDS_BYTES) != hipSuccess) { fprintf(stderr, "kernel_launch: hipFuncSetAttribute failed\n"); grid = -1; return; }
        if (hipOccupancyMaxActiveBlocksPerMultiprocessor(&per_cu, (const void*)fwd_kernel, NTHR, LDS_BYTES) != hipSuccess || per_cu < 1) { fprintf(stderr, "kernel_launch: occupancy query says %d\n", per_cu); per_cu = 1; }
        (void)hipGetLastError();
        grid = cus;
    }
    if (grid < 0) return;
    if (hipMemsetAsync((char*)d_ws + WS_CTL, 0, CTL_ZERO_BYTES, stream) != hipSuccess) { fprintf(stderr, "kernel_launch: hipMemsetAsync failed\n"); return; }
    Args a{};
    for (int i = 0; i < 24; ++i) a.in[i] = (const float*)d_in[i];
    a.out = (float*)d_out; a.ws = (unsigned char*)d_ws;
#if MK_PER_PHASE
    for (int p = 0; p < N_PHASES; ++p) { a.ph_lo = p; a.ph_hi = p + 1; hipLaunchKernelGGL(fwd_kernel, dim3(grid), dim3(NTHR), LDS_BYTES, stream, a); }
#else
    a.ph_lo = 0; a.ph_hi = N_PHASES;
    void* args[] = {&a};
    const hipError_t e = hipLaunchCooperativeKernel((const void*)fwd_kernel, dim3(grid), dim3(NTHR), args, LDS_BYTES, stream);
    if (e != hipSuccess) fprintf(stderr, "kernel_launch: cooperative launch failed: %s (grid %d)\n", hipGetErrorString(e), grid);
#endif
}
```

```cpp
#include <hip/hip_runtime.h>
#include <hip/hip_bf16.h>
#include <hip/hip_cooperative_groups.h>
#include <cstdio>
#include <cstdint>
namespace cg = cooperative_groups;
#ifndef ATT_SDEPTH
#define ATT_SDEPTH 1
#endif
namespace pg8 {
#define PG8_LAS __attribute__((address_space(3)))
typedef unsigned short bf16_t;
typedef short bf16x8 __attribute__((ext_vector_type(8)));
typedef float f32x4 __attribute__((ext_vector_type(4)));
typedef unsigned u32x4 __attribute__((ext_vector_type(4)));
constexpr int BM = 256, BK = 64, HALF = 128, HTB = HALF * BK * 2  , STAGE_BYTES = 8 * HTB, NXCD = 8, WGM = 8;

__host__ __device__ __forceinline__ int lds_byte(int r, int c) { const int st = (r >> 4) * 2 + (c >> 5), rr = r & 15, cc = c & 31, ob = rr * 64 + cc * 2; return st * 1024 + (ob ^ (((ob >> 9) & 1) << 5)); }
__host__ __device__ __forceinline__ void stage_rc(int b, int& R, int& C) { const int st = b / 1024, sb = b % 1024, swz = sb ^ (((sb >> 9) & 1) << 5); R = (st >> 1) * 16 + swz / 64; C = (st & 1) * 32 + (swz % 64) / 2; }
__host__ __device__ __forceinline__ int perm32(int rho) { const int n = rho >> 4, i = rho & 15; return 8 * (i >> 2) + 4 * n + (i & 3); }

struct Unit { int pm, pn; };
struct Gemm { const bf16_t* A; const bf16_t* Bt; int M, N, K; };

struct StaticOrder {
    int nM, nN, nwg, G, c;
    __host__ __device__ void init(int M, int N, int G_, int c_) { nM = M / BM; nN = N / BM; nwg = nM * nN; G = G_; c = c_; }
    __host__ __device__ bool next(int i, Unit& u) const {
        const long L = (long)i * G + c; if (L >= nwg) return false;
        int wgid = (int)L; { const int q = nwg / NXCD, r = nwg % NXCD, xcd = wgid % NXCD, off = wgid / NXCD; wgid = (xcd < r ? xcd * (q + 1) : r * (q + 1) + (xcd - r) * q) + off; }
        const int nig = WGM * nN, gid = wgid / nig, fm = gid * WGM, gsz = (nM - fm) < WGM ? (nM - fm) : WGM;
        u.pm = fm + ((wgid % nig) % gsz); u.pn = (wgid % nig) / gsz; return true;
    }
    __device__ __forceinline__ void a_ready(const Unit&) const {}
    __device__ __forceinline__ void done(const Unit&) const {}
};

__device__ __forceinline__ unsigned cvt_pk_s(float lo, float hi) { typedef float f2 __attribute__((ext_vector_type(2))); typedef __bf16 b2 __attribute__((ext_vector_type(2))); f2 v = {lo, hi}; b2 b = __builtin_convertvector(v, b2); return __builtin_bit_cast(unsigned, b); }
__device__ __forceinline__ u32x4 pack8(f32x4 v0, f32x4 v1) { u32x4 w; w.x = cvt_pk_s(v0[0], v0[1]); w.y = cvt_pk_s(v0[2], v0[3]); w.z = cvt_pk_s(v1[0], v1[1]); w.w = cvt_pk_s(v1[2], v1[3]); return w; }
__device__ __forceinline__ float bflo(unsigned w) { return __builtin_bit_cast(float, w << 16); }
__device__ __forceinline__ float bfhi(unsigned w) { return __builtin_bit_cast(float, w & 0xffff0000u); }
template <class Op> struct EpiOp {
    static constexpr bool PERM = true, AFTER_DRAIN = false;
    Op op;
    __device__ __forceinline__ void operator()(const f32x4 (&acc)[2][2][4][2], const Unit& u, int wr, int wc, int fr, int fq) const {
        const int row0 = u.pm * BM + wr * 64 + fr, col0 = u.pn * BM + wc * 32 + 8 * fq;
#pragma unroll
        for (int ai = 0; ai < 2; ++ai)
#pragma unroll
            for (int m = 0; m < 4; ++m)
#pragma unroll
                for (int bj = 0; bj < 2; ++bj) op(row0 + ai * HALF + m * 16, col0 + bj * HALF, acc[ai][bj][m][0], acc[ai][bj][m][1]);
    }
};
struct OpPlain { static constexpr bool IDEMP = true; bf16_t* O; int ldc;
    __device__ __forceinline__ void operator()(int row, int col, f32x4 v0, f32x4 v1) const { *(u32x4*)(O + (size_t)row * ldc + col) = pack8(v0, v1); } };
struct OpRouteA { static constexpr bool IDEMP = true; bf16_t* cq; bf16_t* ckv; bf16_t* kr; float* bd;
    __device__ __forceinline__ void operator()(int row, int col, f32x4 v0, f32x4 v1) const {
        if (col < 384) *(u32x4*)(cq + (size_t)row * 384 + col) = pack8(v0, v1);
        else if (col < 640) *(u32x4*)(ckv + (size_t)row * 256 + (col - 384)) = pack8(v0, v1);
        else if (col < 704) *(u32x4*)(kr + (size_t)row * 64 + (col - 640)) = pack8(v0, v1);
        else if (col < 736) { float* p = bd + (size_t)row * 32 + (col - 704); *(f32x4*)p = v0; *(f32x4*)(p + 4) = v1; }
    } };
struct OpSplit3 { static constexpr bool IDEMP = true; bf16_t* O; size_t stride; bf16_t* halo;
    __device__ __forceinline__ void operator()(int row, int col, f32x4 v0, f32x4 v1) const { const int t = col >> 10; const u32x4 w = pack8(v0, v1);
        *(u32x4*)(O + (size_t)t * stride + (size_t)row * 1024 + (col & 1023)) = w;
        const int r6 = row & 63;
        if (r6 < 2 || r6 >= 62) { const int slot = r6 < 2 ? r6 : r6 - 60; *(u32x4*)(halo + (((size_t)(row >> 6) * 4 + slot) * 3 + t) * 1024 + (col & 1023)) = w; } } };
struct OpPassA2 { static constexpr bool IDEMP = true; OpRouteA ra; bf16_t* qcx; size_t cst; bf16_t* halo; int row_ctx0;
    __device__ __forceinline__ void operator()(int row, int col, f32x4 v0, f32x4 v1) const {
        if (col >= 6144) { ra(row, col - 6144, v0, v1); return; }
        const int t = col >> 10; const u32x4 w = pack8(v0, v1);
        *(u32x4*)(qcx + (size_t)t * cst + (size_t)(row - row_ctx0) * 1024 + (col & 1023)) = w;
        const int r6 = row & 63;
        if (r6 < 2 || r6 >= 62) { const int slot = r6 < 2 ? r6 : r6 - 60; *(u32x4*)(halo + (((size_t)(row >> 6) * 4 + slot) * 3 + t) * 1024 + (col & 1023)) = w; } } };
struct OpZGate { static constexpr bool IDEMP = true; bf16_t* Z; bf16_t* SG;
    __device__ __forceinline__ void operator()(int row, int col, f32x4 v0, f32x4 v1) const {
        if (col < 1024) { *(u32x4*)(Z + (size_t)row * 1024 + col) = pack8(v0, v1); return; }
#pragma unroll
        for (int i = 0; i < 4; ++i) { v0[i] = __builtin_amdgcn_rcpf(1.f + __expf(-v0[i])); v1[i] = __builtin_amdgcn_rcpf(1.f + __expf(-v1[i])); }
        *(u32x4*)(SG + (size_t)row * 2048 + (col - 1024)) = pack8(v0, v1);
    } };
template <bool ADD> struct OpGate { static constexpr bool IDEMP = !ADD; bf16_t* Y; const bf16_t* SG; int goff;
    __device__ __forceinline__ void operator()(int row, int col, f32x4 v0, f32x4 v1) const {
        const u32x4 g = *(const u32x4*)(SG + (size_t)row * 2048 + goff + col);
        f32x4 a0 = {bflo(g.x), bfhi(g.x), bflo(g.y), bfhi(g.y)}, a1 = {bflo(g.z), bfhi(g.z), bflo(g.w), bfhi(g.w)};
        v0 = v0 * a0; v1 = v1 * a1;
        bf16_t* yp = Y + (size_t)row * 1024 + col;
        if (ADD) { const u32x4 y = *(const u32x4*)yp; f32x4 y0 = {bflo(y.x), bfhi(y.x), bflo(y.y), bfhi(y.y)}, y1 = {bflo(y.z), bfhi(y.z), bflo(y.w), bfhi(y.w)}; v0 = v0 + y0; v1 = v1 + y1; }
        *(u32x4*)yp = pack8(v0, v1);
    } };
struct OpResid { static constexpr bool IDEMP = false; const float* base; float* out; const float* gate;
    __device__ __forceinline__ void operator()(int row, int col, f32x4 v0, f32x4 v1) const {
        const float* gp = gate + (size_t)(row >> 13) * 6144 + col; const size_t off = (size_t)row * 1024 + col;
        const f32x4 g0 = *(const f32x4*)gp, g1 = *(const f32x4*)(gp + 4), b0 = *(const f32x4*)(base + off), b1 = *(const f32x4*)(base + off + 4);
        *(f32x4*)(out + off) = b0 + g0 * v0; *(f32x4*)(out + off + 4) = b1 + g1 * v1;
    } };
struct OpRelu2 { static constexpr bool IDEMP = true; bf16_t* O;
    __device__ __forceinline__ void operator()(int row, int col, f32x4 v0, f32x4 v1) const {
#pragma unroll
        for (int i = 0; i < 4; ++i) { const float a = fmaxf(v0[i], 0.f), b = fmaxf(v1[i], 0.f); v0[i] = a * a; v1[i] = b * b; }
        *(u32x4*)(O + (size_t)row * 4096 + col) = pack8(v0, v1);
    } };
template <class Epi, class Sched, bool ALIGN_EPI = false, bool SP2 = false>
__device__ __forceinline__ void gemm_phase(PG8_LAS unsigned char* lds, const Gemm g, const Sched& S, const Epi& E) {
    int tid_ = threadIdx.x; asm volatile("" : "+v"(tid_));
    const int tid = tid_, wid = __builtin_amdgcn_readfirstlane(tid >> 6), lane = tid & 63, wr = wid >> 2, wc = wid & 3, fr = lane & 15, fq = lane >> 4;
    const int K = g.K, nt = K / BK;
    unsigned voffA[2], voffB[2];
#pragma unroll
    for (int i = 0; i < 2; ++i) { int R, C; stage_rc(tid * 16 + i * 8192, R, C); const int Rb = Epi::PERM ? ((R & ~31) + perm32(R & 31)) : R;
        voffA[i] = (unsigned)(R * K + C) * 2u; voffB[i] = (unsigned)(Rb * K + C) * 2u; }
    const size_t kstep = (size_t)(BK * 2);
    const size_t hstep = (size_t)HALF * K * 2;
    const size_t tstep = 2 * hstep;
    const unsigned ldsw = (unsigned)wid * 1024u;
    const int aoff = lds_byte(wr * 64 + fr, fq * 8), boff = lds_byte(wc * 32 + fr, fq * 8);
#define PG8_SA(b, h) (((b) * 2 + (h)) * HTB)
#define PG8_SB(b, h) ((4 + (b) * 2 + (h)) * HTB)
#define PG8_STAGE(bufoff, gbase, voff) do { _Pragma("unroll") for (int _i = 0; _i < 2; ++_i) \
        __builtin_amdgcn_global_load_lds((const unsigned*)((const char*)(gbase) + (voff)[_i]), (PG8_LAS unsigned*)(lds + (bufoff) + ldsw + _i * 8192), 16, 0, 0); } while (0)
#define PG8_LDA(dst, b, h) do { _Pragma("unroll") for (int m = 0; m < 4; ++m) _Pragma("unroll") for (int k = 0; k < 2; ++k) dst[m][k] = *(const PG8_LAS bf16x8*)(lds + PG8_SA(b, h) + aoff + m * 2048 + k * 1024); } while (0)
#define PG8_LDB(dst, b, h) do { _Pragma("unroll") for (int n = 0; n < 2; ++n) _Pragma("unroll") for (int k = 0; k < 2; ++k) dst[n][k] = *(const PG8_LAS bf16x8*)(lds + PG8_SB(b, h) + boff + n * 2048 + k * 1024); } while (0)
#define PG8_MMA(ai, bj, At, Bt) do { __builtin_amdgcn_s_setprio(1); _Pragma("unroll") for (int m = 0; m < 4; ++m) _Pragma("unroll") for (int n = 0; n < 2; ++n) _Pragma("unroll") for (int k = 0; k < 2; ++k) \
        acc[ai][bj][m][n] = __builtin_amdgcn_mfma_f32_16x16x32_bf16(Bt[n][k], At[m][k], acc[ai][bj][m][n], 0, 0, 0); __builtin_amdgcn_s_setprio(0); } while (0)
#define PG8_WAIT_V(n) asm volatile("s_waitcnt vmcnt(" #n ")" ::: "memory")
#define PG8_WAIT_L(n) asm volatile("s_waitcnt lgkmcnt(" #n ")" ::: "memory")
#define PG8_BAR __builtin_amdgcn_s_barrier()
#define PG8_SCHED __builtin_amdgcn_sched_barrier(0)
    Unit cur, nxt; int ui = 0;
    if (!S.next(0, cur)) return;
    f32x4 acc[2][2][4][2];
#pragma unroll
    for (int a = 0; a < 2; ++a)
#pragma unroll
        for (int b = 0; b < 2; ++b)
#pragma unroll
            for (int m = 0; m < 4; ++m)
#pragma unroll
                for (int n = 0; n < 2; ++n) acc[a][b][m][n] = (f32x4){0.f, 0.f, 0.f, 0.f};
    bf16x8 At[4][2], B0[2][2], B1[2][2];
    const char* cA = (const char*)g.A + (size_t)cur.pm * tstep; const char* cB = (const char*)g.Bt + (size_t)cur.pn * tstep;
    S.a_ready(cur);
    if constexpr (SP2) {
        PG8_STAGE(PG8_SB(0, 0), cB, voffB); PG8_STAGE(PG8_SB(0, 1), cB + hstep, voffB); PG8_STAGE(PG8_SA(0, 0), cA, voffA); PG8_STAGE(PG8_SA(0, 1), cA + hstep, voffA);
        if (wr == 1) PG8_BAR;
        PG8_WAIT_V(2); PG8_BAR;
        PG8_STAGE(PG8_SB(1, 0), cB + kstep, voffB); PG8_STAGE(PG8_SA(1, 0), cA + kstep, voffA); PG8_STAGE(PG8_SB(1, 1), cB + hstep + kstep, voffB);
        PG8_WAIT_V(6); PG8_BAR;
    } else {
        PG8_STAGE(PG8_SB(0, 0), cB, voffB); PG8_STAGE(PG8_SA(0, 0), cA, voffA); PG8_STAGE(PG8_SB(0, 1), cB + hstep, voffB); PG8_STAGE(PG8_SA(0, 1), cA + hstep, voffA);
        if (wr == 1) PG8_BAR;
        PG8_WAIT_V(4); PG8_BAR;
        PG8_STAGE(PG8_SB(1, 0), cB + kstep, voffB); PG8_STAGE(PG8_SA(1, 0), cA + kstep, voffA); PG8_STAGE(PG8_SB(1, 1), cB + hstep + kstep, voffB);
        PG8_WAIT_V(6); PG8_BAR;
    }
    for (;;) {
        const bool has_next = S.next(ui + 1, nxt);
        const char* nA = has_next ? (const char*)g.A + (size_t)nxt.pm * tstep : cA; const char* nB = has_next ? (const char*)g.Bt + (size_t)nxt.pn * tstep : cB;
        for (int t = 0; t < nt; t += 2) {
            const bool last = (t == nt - 2);
            const char* a1 = cA + (size_t)(t + 1) * kstep;
            const char* a2 = last ? nA : cA + (size_t)(t + 2) * kstep; const char* b2 = last ? nB : cB + (size_t)(t + 2) * kstep;
            const char* a3 = a2 + kstep; const char* b3 = b2 + kstep;
            if (last && has_next) S.a_ready(nxt);
            if constexpr (SP2) {
            PG8_LDB(B0, 0, 0); PG8_LDB(B1, 0, 1); PG8_SCHED; PG8_LDA(At, 0, 0); PG8_STAGE(PG8_SA(1, 1), a1 + hstep, voffA);
            PG8_WAIT_V(8); PG8_WAIT_L(0); PG8_BAR; PG8_MMA(0, 0, At, B0); PG8_MMA(0, 1, At, B1); PG8_BAR; PG8_SCHED;
            PG8_LDA(At, 0, 1); PG8_STAGE(PG8_SB(0, 0), b2, voffB); PG8_STAGE(PG8_SB(0, 1), b2 + hstep, voffB); PG8_STAGE(PG8_SA(0, 0), a2, voffA);
            PG8_WAIT_V(8); PG8_WAIT_L(0); PG8_BAR; PG8_MMA(1, 0, At, B0); PG8_MMA(1, 1, At, B1); PG8_BAR; PG8_SCHED;
            PG8_LDB(B0, 1, 0); PG8_LDB(B1, 1, 1); PG8_SCHED; PG8_LDA(At, 1, 0); PG8_STAGE(PG8_SA(0, 1), a2 + hstep, voffA);
            PG8_WAIT_V(8); PG8_WAIT_L(0); PG8_BAR; PG8_MMA(0, 0, At, B0); PG8_MMA(0, 1, At, B1); PG8_BAR; PG8_SCHED;
            PG8_LDA(At, 1, 1); PG8_STAGE(PG8_SB(1, 0), b3, voffB); PG8_STAGE(PG8_SB(1, 1), b3 + hstep, voffB); PG8_STAGE(PG8_SA(1, 0), a3, voffA);
            PG8_WAIT_V(8); PG8_WAIT_L(0); PG8_BAR; PG8_MMA(1, 0, At, B0); PG8_MMA(1, 1, At, B1); PG8_BAR; PG8_SCHED;
            } else {
            PG8_LDB(B0, 0, 0); PG8_SCHED; PG8_LDA(At, 0, 0); PG8_STAGE(PG8_SA(1, 1), a1 + hstep, voffA);
            PG8_WAIT_L(8); PG8_BAR; PG8_WAIT_L(0); PG8_MMA(0, 0, At, B0); PG8_BAR; PG8_SCHED;
            PG8_LDB(B1, 0, 1); PG8_STAGE(PG8_SB(0, 0), b2, voffB);
            PG8_BAR; PG8_WAIT_L(0); PG8_MMA(0, 1, At, B1); PG8_BAR;
            PG8_LDA(At, 0, 1); PG8_STAGE(PG8_SA(0, 0), a2, voffA);
            PG8_BAR; PG8_WAIT_L(0); PG8_MMA(1, 0, At, B0); PG8_BAR; PG8_SCHED;
            PG8_STAGE(PG8_SB(0, 1), b2 + hstep, voffB);
            PG8_WAIT_V(6); PG8_BAR; PG8_MMA(1, 1, At, B1); PG8_BAR;
            PG8_LDB(B0, 1, 0); PG8_SCHED; PG8_LDA(At, 1, 0); PG8_STAGE(PG8_SA(0, 1), a2 + hstep, voffA);
            PG8_WAIT_L(8); PG8_BAR; PG8_WAIT_L(0); PG8_MMA(0, 0, At, B0); PG8_BAR; PG8_SCHED;
            PG8_LDB(B1, 1, 1); PG8_STAGE(PG8_SB(1, 0), b3, voffB);
            PG8_BAR; PG8_WAIT_L(0); PG8_MMA(0, 1, At, B1); PG8_BAR;
            PG8_LDA(At, 1, 1); PG8_STAGE(PG8_SA(1, 0), a3, voffA);
            PG8_BAR; PG8_WAIT_L(0); PG8_MMA(1, 0, At, B0); PG8_BAR; PG8_SCHED;
            PG8_STAGE(PG8_SB(1, 1), b3 + hstep, voffB);
            PG8_WAIT_V(6); PG8_BAR; PG8_MMA(1, 1, At, B1); PG8_BAR;
            }
        }
        if constexpr (ALIGN_EPI) { if (wr == 0) PG8_BAR; }
        if constexpr (!Epi::AFTER_DRAIN) { E(acc, cur, wr, wc, fr, fq); S.done(cur); }
        if (!has_next) break;
#pragma unroll
        for (int a = 0; a < 2; ++a)
#pragma unroll
            for (int b = 0; b < 2; ++b)
#pragma unroll
                for (int m = 0; m < 4; ++m)
#pragma unroll
                    for (int n = 0; n < 2; ++n) acc[a][b][m][n] = (f32x4){0.f, 0.f, 0.f, 0.f};
        cur = nxt; cA = nA; cB = nB; ++ui;
        if constexpr (ALIGN_EPI) { if (wr == 1) PG8_BAR; }
    }
    PG8_WAIT_V(0);
    if constexpr (!ALIGN_EPI) { if (wr == 0) PG8_BAR; }
    PG8_BAR;
    if constexpr (Epi::AFTER_DRAIN) { E.fused(acc, cur, wr, wc, fr, fq, lds, wid, lane); S.done(cur); }
#undef PG8_SA
#undef PG8_SB
#undef PG8_STAGE
#undef PG8_LDA
#undef PG8_LDB
#undef PG8_MMA
#undef PG8_WAIT_V
#undef PG8_WAIT_L
#undef PG8_BAR
#undef PG8_SCHED
}
}
namespace att {
using bf16 = __hip_bfloat16;
constexpr int DQK = 192, DV = 128, NW = 8, QBLK = 32, KVBLK = 64;
constexpr float SCALE = 0.07216878364870323f;
constexpr float THR = 8.f;
constexpr int LDQ = 1536, LDK = 1536, LDV = 2048, LDO = 1024;
#ifndef QKT_GRP
#define QKT_GRP 4
#endif
#ifndef ATT_NQREG
#define ATT_NQREG 12
#endif
constexpr int NQREG = ATT_NQREG;
constexpr int SHM_V = KVBLK * DV * 2, SHM_K = KVBLK * 400, SHM_QL = 2 * SHM_V + 2 * SHM_K + NW * 64 * 4, SHM_ATTN = SHM_QL + NW * (12 - NQREG) * 1024;
using bf16x8 = __attribute__((ext_vector_type(8))) short;
using s16x4  = __attribute__((ext_vector_type(4))) short;
using f32x16 = __attribute__((ext_vector_type(16))) float;
using u32x4  = __attribute__((ext_vector_type(4))) unsigned;
#define KSWZ(row, colB) ((row) * 400 + (colB))
#define SBAR() __builtin_amdgcn_sched_barrier(0)
__device__ __forceinline__ int crow(int r, int hi) { return (r & 3) + 8 * (r >> 2) + 4 * hi; }
__device__ __forceinline__ unsigned cvtpk(float lo, float hi) { unsigned r; asm volatile("v_cvt_pk_bf16_f32 %0, %1, %2" : "=v"(r) : "v"(lo), "v"(hi)); return r; }
__device__ __forceinline__ void partialSM(f32x16& p0, f32x16& p1, float& m_reg, float& mn, float& alpha) {
  constexpr float C = SCALE * 1.4426950408889634f;
  float pmax = p0[0]; for (int r = 1; r < 16; ++r) pmax = fmaxf(pmax, p0[r]); for (int r = 0; r < 16; ++r) pmax = fmaxf(pmax, p1[r]);
  { auto rr = __builtin_amdgcn_permlane32_swap(__float_as_uint(pmax), __float_as_uint(pmax), false, false);
    pmax = fmaxf(__uint_as_float(rr[0]), __uint_as_float(rr[1])); }
  if (__builtin_expect(__all(pmax - m_reg <= THR / SCALE), 1)) { mn = m_reg; alpha = 1.f; }
  else { mn = fmaxf(m_reg, pmax); alpha = __builtin_amdgcn_exp2f((m_reg - mn) * C); m_reg = mn; }
  float mnC = -mn * C;
  for (int r = 0; r < 16; ++r) p0[r] = fmaf(p0[r], C, mnC); for (int r = 0; r < 16; ++r) p1[r] = fmaf(p1[r], C, mnC);
  for (int r = 0; r < 16; ++r) p0[r] = __builtin_amdgcn_exp2f(p0[r]);
}
__device__ __forceinline__ void finishSM(f32x16& p0, f32x16& p1, float alpha, float& l_reg, bf16x8& pa0, bf16x8& pa1, bf16x8& pa2, bf16x8& pa3) {
  for (int r = 0; r < 16; ++r) p1[r] = __builtin_amdgcn_exp2f(p1[r]);
  float ps = 0; for (int r = 0; r < 16; ++r) ps += p0[r]; for (int r = 0; r < 16; ++r) ps += p1[r];
  { auto rr = __builtin_amdgcn_permlane32_swap(__float_as_uint(ps), __float_as_uint(ps), false, false);
    ps = __uint_as_float(rr[0]) + __uint_as_float(rr[1]); }
  l_reg = l_reg * alpha + ps;
#define PK4(P, BASE, OUT) do { unsigned a0 = cvtpk(P[BASE + 0], P[BASE + 1]), a1 = cvtpk(P[BASE + 2], P[BASE + 3]);   \
    unsigned b0 = cvtpk(P[BASE + 4], P[BASE + 5]), b1 = cvtpk(P[BASE + 6], P[BASE + 7]);                              \
    auto r0 = __builtin_amdgcn_permlane32_swap(a0, b0, false, false); auto r1 = __builtin_amdgcn_permlane32_swap(a1, b1, false, false); \
    u32x4 w = {r0[0], r1[0], r0[1], r1[1]}; OUT = *reinterpret_cast<bf16x8*>(&w); } while (0)
  PK4(p0, 0, pa0); PK4(p0, 8, pa1); PK4(p1, 0, pa2); PK4(p1, 8, pa3);
#undef PK4
}
__device__ __forceinline__ void qkt(f32x16& p0, f32x16& p1, const bf16* Ks, const bf16x8* qr, const bf16x8* qL, int r32, int hi) {
  p0 = f32x16{}; p1 = f32x16{};
#pragma unroll
  for (int d0 = 0; d0 < 12; ++d0) { int cb = (d0 * 16 + hi * 8) * 2;
    bf16x8 b0 = *reinterpret_cast<const bf16x8*>((const char*)Ks + KSWZ(r32, cb));
    bf16x8 b1 = *reinterpret_cast<const bf16x8*>((const char*)Ks + KSWZ(32 + r32, cb));
    const bf16x8 qf = (d0 < NQREG) ? qr[d0 < NQREG ? d0 : 0] : qL[(d0 - NQREG) * 64];
    p0 = __builtin_amdgcn_mfma_f32_32x32x16_bf16(b0, qf, p0, 0, 0, 0);
    p1 = __builtin_amdgcn_mfma_f32_32x32x16_bf16(b1, qf, p1, 0, 0, 0);
    if ((d0 & (QKT_GRP - 1)) == QKT_GRP - 1 && d0 != 11) SBAR(); }
}
__device__ __forceinline__ int v_st(int k, int c) { const int kk = (k & ~0xC) | ((k & 4) << 1) | ((k & 8) >> 1); return ((kk >> 3) * 4 + (c >> 5)) * 512 + ((kk & 7) * 32 + (c & 31)) * 2; }
__device__ __forceinline__ int v_rd_base(int lane) { return ((lane & 3) << 3) | (((lane >> 2) & 3) << 6) | (((lane >> 4) & 1) << 5) | (((lane >> 5) & 1) << 8); }
constexpr int v_rd_off(int d0, int ks, int half) { return d0 * 512 + ks * 4096 + half * 2048; }
template <int OFF> __device__ __forceinline__ s16x4 tr_read(int vb) {
  s16x4 r; asm volatile("ds_read_b64_tr_b16 %0, %1 offset:%2" : "=&v"(r) : "v"(vb), "i"(OFF) : "memory"); return r;
}
template <int D0> __device__ __forceinline__ void pv_one(f32x16& od, int vb, bf16x8 pa0, bf16x8 pa1, bf16x8 pa2, bf16x8 pa3) {
  const s16x4 l0 = tr_read<v_rd_off(D0, 0, 0)>(vb), h0 = tr_read<v_rd_off(D0, 0, 1)>(vb), l1 = tr_read<v_rd_off(D0, 1, 0)>(vb), h1 = tr_read<v_rd_off(D0, 1, 1)>(vb);
  const s16x4 l2 = tr_read<v_rd_off(D0, 2, 0)>(vb), h2 = tr_read<v_rd_off(D0, 2, 1)>(vb), l3 = tr_read<v_rd_off(D0, 3, 0)>(vb), h3 = tr_read<v_rd_off(D0, 3, 1)>(vb);
  asm volatile("s_waitcnt lgkmcnt(0)" ::: "memory"); SBAR();
#define PK(L, H) (bf16x8){L[0], L[1], L[2], L[3], H[0], H[1], H[2], H[3]}
  od = __builtin_amdgcn_mfma_f32_32x32x16_bf16(pa0, PK(l0, h0), od, 0, 0, 0);
  od = __builtin_amdgcn_mfma_f32_32x32x16_bf16(pa1, PK(l1, h1), od, 0, 0, 0);
  od = __builtin_amdgcn_mfma_f32_32x32x16_bf16(pa2, PK(l2, h2), od, 0, 0, 0);
  od = __builtin_amdgcn_mfma_f32_32x32x16_bf16(pa3, PK(l3, h3), od, 0, 0, 0);
#undef PK
}
__device__ __forceinline__ void pv_d0(f32x16* o, int vb, bf16x8 pa0, bf16x8 pa1, bf16x8 pa2, bf16x8 pa3) {
  pv_one<0>(o[0], vb, pa0, pa1, pa2, pa3); pv_one<1>(o[1], vb, pa0, pa1, pa2, pa3); pv_one<2>(o[2], vb, pa0, pa1, pa2, pa3); pv_one<3>(o[3], vb, pa0, pa1, pa2, pa3);
}
template <int SDEPTH>
__device__ __forceinline__ void attn_dense_body(const bf16* __restrict__ Qb, const bf16* __restrict__ Kc, const bf16* __restrict__ Kl, const bf16* __restrict__ Vc, const bf16* __restrict__ Vl,
                                                bf16* __restrict__ Ob, int seq, char* lds) {
  const int tid = threadIdx.x, wid = tid >> 6, lane = tid & 63, r32 = lane & 31, hi = lane >> 5;
  bf16* V_lds = (bf16*)lds; bf16* K_lds = (bf16*)(lds + 2 * SHM_V);
  float* ws = (float*)(lds + 2 * SHM_V + 2 * SHM_K) + wid * 64; float* li_l = ws; float* al_l = ws + 32;
  float m_reg = -1e30f, l_reg = 0; f32x16 o[4] = {}; bf16x8 qr[NQREG];
  bf16x8* qL = (bf16x8*)(lds + SHM_QL) + wid * (12 - NQREG) * 64 + lane;
  const bf16* Qw = Qb + (long)(wid * QBLK + r32) * LDQ + hi * 8;
#pragma unroll
  for (int d0 = 0; d0 < 12; ++d0) { const bf16x8 qv = *reinterpret_cast<const bf16x8*>(Qw + d0 * 16); if (d0 < NQREG) qr[d0 < NQREG ? d0 : 0] = qv; else qL[(d0 - NQREG) * 64] = qv; }
  const int sr = tid >> 4, sc = (tid & 15) * 8, vst0 = v_st(sr, sc), vst1 = v_st(32 + sr, sc);
  const int kr0 = tid / 24, kc0 = (tid % 24) * 8, kr1 = (tid + 512) / 24, kc1 = ((tid + 512) % 24) * 8, kr2 = (tid + 1024) / 24, kc2 = ((tid + 1024) % 24) * 8;
  const int kw0 = KSWZ(kr0, kc0 * 2), kw1 = KSWZ(kr1, kc1 * 2), kw2 = KSWZ(kr2, kc2 * 2);
  const int vb0 = (int)(uintptr_t)V_lds + v_rd_base(lane);
  struct { bf16x8 vs0, vs1, ks0, ks1, ks2; } sr_[SDEPTH];
#define KP(k0) ((k0) < 256 ? Kc + (long)(k0) * LDK : Kl + (long)((k0) - 256) * LDK)
#define VP(k0) ((k0) < 256 ? Vc + (long)(k0) * LDV : Vl + (long)((k0) - 256) * LDV)
#define SLOAD(i, k0) do { const bf16* kp_ = KP(k0); const bf16* vp_ = VP(k0); \
    sr_[i].vs0 = *reinterpret_cast<const bf16x8*>(&vp_[(long)sr * LDV + sc]); sr_[i].vs1 = *reinterpret_cast<const bf16x8*>(&vp_[(long)(32 + sr) * LDV + sc]); \
    sr_[i].ks0 = *reinterpret_cast<const bf16x8*>(&kp_[(long)kr0 * LDK + kc0]); sr_[i].ks1 = *reinterpret_cast<const bf16x8*>(&kp_[(long)kr1 * LDK + kc1]); \
    sr_[i].ks2 = *reinterpret_cast<const bf16x8*>(&kp_[(long)kr2 * LDK + kc2]); } while (0)
#define SWRITE(b, i) do { *(bf16x8*)((char*)V_lds + (b) * SHM_V + vst0) = sr_[i].vs0; *(bf16x8*)((char*)V_lds + (b) * SHM_V + vst1) = sr_[i].vs1; \
    *(bf16x8*)((char*)K_lds + (b) * SHM_K + kw0) = sr_[i].ks0; *(bf16x8*)((char*)K_lds + (b) * SHM_K + kw1) = sr_[i].ks1; *(bf16x8*)((char*)K_lds + (b) * SHM_K + kw2) = sr_[i].ks2; } while (0)
#define SWAIT() do { if constexpr (SDEPTH == 2) asm volatile("s_waitcnt vmcnt(5)" ::: "memory"); else asm volatile("s_waitcnt vmcnt(0)" ::: "memory"); } while (0)
#define RESC(a) do { if (__any((a) < 1.f)) { if (hi == 0) al_l[r32] = (a); asm volatile("s_waitcnt lgkmcnt(0)" ::: "memory"); \
    for (int d = 0; d < 4; ++d) for (int r = 0; r < 16; ++r) o[d][r] *= al_l[crow(r, hi)]; } } while (0)
  f32x16 pA0, pA1, pB0, pB1; float mnA, mnB, alA, alB; bf16x8 pa0, pa1, pa2, pa3; const int NT = seq / KVBLK;
  constexpr int SE = 0, SO = SDEPTH - 1;
  SLOAD(SE, 0); asm volatile("s_waitcnt vmcnt(0)" ::: "memory"); SWRITE(0, SE); __syncthreads();
  qkt(pA0, pA1, K_lds, qr, qL, r32, hi); partialSM(pA0, pA1, m_reg, mnA, alA);
  SLOAD(SO, KVBLK); if constexpr (SDEPTH == 2) { if (2 < NT) SLOAD(SE, 2 * KVBLK); }
  SWAIT(); SWRITE(1, SO); __syncthreads();
  for (int j = 1; j + 1 < NT; j += 2) {
    SBAR(); qkt(pB0, pB1, (bf16*)((char*)K_lds + SHM_K), qr, qL, r32, hi);
    finishSM(pA0, pA1, alA, l_reg, pa0, pa1, pa2, pa3); SBAR();
    SLOAD(SO, (j + SDEPTH) * KVBLK); SBAR();
    pv_d0(o, vb0, pa0, pa1, pa2, pa3); partialSM(pB0, pB1, m_reg, mnB, alB);
    __syncthreads(); SWAIT(); SWRITE(0, SE);
    RESC(alB); __syncthreads();
    SBAR(); qkt(pA0, pA1, K_lds, qr, qL, r32, hi);
    finishSM(pB0, pB1, alB, l_reg, pa0, pa1, pa2, pa3); SBAR();
    if (SDEPTH == 1 || j + 3 < NT) SLOAD(SE, (j + 1 + SDEPTH) * KVBLK); SBAR();
    pv_d0(o, vb0 + (int)SHM_V, pa0, pa1, pa2, pa3); partialSM(pA0, pA1, m_reg, mnA, alA);
    __syncthreads(); SWAIT(); SWRITE(1, SO);
    RESC(alA); __syncthreads();
  }
  SBAR(); qkt(pB0, pB1, (bf16*)((char*)K_lds + SHM_K), qr, qL, r32, hi);
  finishSM(pA0, pA1, alA, l_reg, pa0, pa1, pa2, pa3); SBAR();
  pv_d0(o, vb0, pa0, pa1, pa2, pa3); partialSM(pB0, pB1, m_reg, mnB, alB);
  __syncthreads(); RESC(alB);
  finishSM(pB0, pB1, alB, l_reg, pa0, pa1, pa2, pa3); SBAR();
  pv_d0(o, vb0 + (int)SHM_V, pa0, pa1, pa2, pa3);
  if (hi == 0) li_l[r32] = l_reg; asm volatile("s_waitcnt lgkmcnt(0)" ::: "memory");
  float rli[16];
#pragma unroll
  for (int r = 0; r < 16; ++r) rli[r] = __builtin_amdgcn_rcpf(li_l[crow(r, hi)]);
  bf16* Ow = Ob + (long)(wid * QBLK) * LDO;
#pragma unroll
  for (int r = 0; r < 16; ++r) { int orow = crow(r, hi);
#pragma unroll
    for (int d0 = 0; d0 < 4; ++d0) Ow[(long)orow * LDO + d0 * 32 + r32] = __float2bfloat16(o[d0][r] * rli[r]); }
  __syncthreads();
#undef KP
#undef VP
#undef SLOAD
#undef SWRITE
#undef SWAIT
#undef RESC
}
#undef KSWZ
#undef SBAR
}
constexpr int DM = 1024, NBAT = 4, SEQ = 8192, CTXL = 256, ML = NBAT * SEQ, MC = NBAT * CTXL, MT = ML + MC;
constexpr int INC = 6880, NMODC = 6144;
constexpr float EPS = 1e-6f;
constexpr int NWAVES = 8, NTHR = 512;
constexpr size_t MiB = 1u << 20;
constexpr size_t WS_CTL = 0, CTL_ZERO_BYTES = 65536; constexpr int CW_BAR = 1024;
constexpr size_t WS_ROPE = 1 * MiB + 512 * 1024;
constexpr size_t WS_MOD = 1 * MiB, WS_WIN = 2 * MiB, WS_WUQ = 16 * MiB, WS_WUKV = 18 * MiB, WS_WBG = 20 * MiB, WS_WBM = 22 * MiB, WS_WOUT = 24 * MiB, WS_WM1 = 26 * MiB, WS_WM2 = 34 * MiB;
constexpr size_t WS_BD = 42 * MiB, WS_GCU = 47 * MiB, WS_BTU = 50 * MiB, WS_HALO = 53 * MiB, WS_TCTX = 66 * MiB, WS_H = 68 * MiB;
constexpr size_t WS_CQ = 134 * MiB, WS_CKV = 159 * MiB, WS_KR = 176 * MiB, WS_KVRAW = 181 * MiB, WS_KF = 313 * MiB, WS_O = 448 * MiB;
constexpr size_t WS_QR = 134 * MiB, QKV_STRIDE = (size_t)MT * 1024  , WS_OF = 332 * MiB;
constexpr size_t WS_Z = 134 * MiB, WS_SG = 200 * MiB, WS_Y = 134 * MiB, WS_HID = 134 * MiB, WS_END = 512 * MiB;
constexpr int LDS_BYTES = 163840;

#define LAS __attribute__((address_space(3)))
typedef unsigned short bf16_t;
typedef short bf16x8 __attribute__((ext_vector_type(8)));
typedef float f32x4 __attribute__((ext_vector_type(4)));
typedef float f32x16 __attribute__((ext_vector_type(16)));
typedef unsigned u32x4 __attribute__((ext_vector_type(4)));
typedef unsigned u32x2 __attribute__((ext_vector_type(2)));
#define LDS_WAIT() asm volatile("s_waitcnt lgkmcnt(0)" ::: "memory")
__device__ __forceinline__ unsigned pk2(float lo, float hi) { return pg8::cvt_pk_s(lo, hi); }
__device__ __forceinline__ float bflo(unsigned w) { return __builtin_bit_cast(float, w << 16); }
__device__ __forceinline__ float bfhi(unsigned w) { return __builtin_bit_cast(float, w & 0xffff0000u); }
__device__ __forceinline__ float bf1(bf16_t h) { return __builtin_bit_cast(float, (unsigned)h << 16); }
__device__ __forceinline__ bf16_t f2bf(float f) { return (bf16_t)(pk2(f, 0.f) & 0xffffu); }
__device__ __forceinline__ void unpack8(u32x4 w, float* f) { f[0] = bflo(w.x); f[1] = bfhi(w.x); f[2] = bflo(w.y); f[3] = bfhi(w.y); f[4] = bflo(w.z); f[5] = bfhi(w.z); f[6] = bflo(w.w); f[7] = bfhi(w.w); }
__device__ __forceinline__ u32x4 pack8f(const float* f) { u32x4 w; w.x = pk2(f[0], f[1]); w.y = pk2(f[2], f[3]); w.z = pk2(f[4], f[5]); w.w = pk2(f[6], f[7]); return w; }
__device__ __forceinline__ float wave_sum(float v) {
#pragma unroll
    for (int o = 1; o < 64; o <<= 1) v += __shfl_xor(v, o);
    return v;
}
__device__ __forceinline__ float siluf(float x) { return x * __builtin_amdgcn_rcpf(1.f + __expf(-x)); }
__device__ __forceinline__ float rsqf(float x) { return __builtin_amdgcn_rsqf(x); }
__device__ __forceinline__ int crow(int r, int hi) { return (r & 3) + 8 * (r >> 2) + 4 * hi; }
#define MFMA32(a, b, c) __builtin_amdgcn_mfma_f32_32x32x16_bf16((a), (b), (c), 0, 0, 0)

struct Args { const float* in[24]; float* out; unsigned char* ws; int ph_lo, ph_hi; };

__device__ __forceinline__ void transpose_item(const float* W, int ldw, int col0, int K, bf16_t* WT, int row0, int nblk, LAS float* scr, int item, int lane) {
    const int kb = item / nblk, nb = item % nblk, k0 = 64 * kb, n0 = 32 * nb;
    float tw_[32];
#pragma unroll
    for (int i = 0; i < 32; ++i) { const int kk = 2 * i + (lane >> 5); tw_[i] = W[(size_t)(k0 + kk) * ldw + col0 + n0 + (lane & 31)]; }
#pragma unroll
    for (int i = 0; i < 32; ++i) { const int kk = 2 * i + (lane >> 5); scr[kk * 33 + (lane & 31)] = tw_[i]; }
    LDS_WAIT(); asm volatile("" ::: "memory");
    const int c = lane & 7;
#pragma unroll
    for (int j = 0; j < 4; ++j) { const int n = (lane >> 3) + 8 * j; const LAS float* s = scr + (8 * c) * 33 + n;
        u32x4 o; o.x = pk2(s[0 * 33], s[1 * 33]); o.y = pk2(s[2 * 33], s[3 * 33]); o.z = pk2(s[4 * 33], s[5 * 33]); o.w = pk2(s[6 * 33], s[7 * 33]);
        *(u32x4*)(WT + (size_t)(row0 + n0 + n) * K + k0 + 8 * c) = o; }
    LDS_WAIT(); asm volatile("" ::: "memory");
}
__device__ __forceinline__ void p0_prologue(const Args& a, LAS unsigned char* lds, int tid, int lane, int wave) {
    unsigned char* ws = a.ws;
    LAS float* scr = (LAS float*)(lds + wave * 16384);
    const int gw = blockIdx.x * NWAVES + wave, NGW = gridDim.x * NWAVES;
    bf16_t* WIN = (bf16_t*)(ws + WS_WIN);
    int total = 0;
#define REGION_COUNT(inidx, ldw, col0, nc, K, dst, row0) total += ((K) / 64) * ((nc) / 32);
#define REGION_RUN(inidx, ldw, col0, nc, K, dst, row0) { const int n_ = ((K) / 64) * ((nc) / 32); \
        if (rem >= 0 && rem < n_) transpose_item(a.in[inidx], ldw, col0, K, (bf16_t*)(ws + (dst)), row0, (nc) / 32, scr, rem, lane); rem -= n_; }
#define REGIONS(X) X(8, INC, 0, 4096, 1024, WS_WIN, 0) X(8, INC, 4832, 2048, 1024, WS_WIN, 4096) X(8, INC, 4128, 704, 1024, WS_WIN, 6144) X(8, INC, 4096, 32, 1024, WS_WIN, 6848) \
        X(15, 1536, 0, 1536, 384, WS_WUQ, 0) X(16, 2048, 0, 2048, 256, WS_WUKV, 0) X(19, 1024, 0, 1024, 1024, WS_WBG, 0) X(20, 1024, 0, 1024, 1024, WS_WBM, 0) \
        X(21, 1024, 0, 1024, 1024, WS_WOUT, 0) X(22, 4096, 0, 4096, 1024, WS_WM1, 0) X(23, 1024, 0, 1024, 4096, WS_WM2, 0)
    REGIONS(REGION_COUNT)
    for (int it = gw; it < total; it += NGW) { int rem = it; REGIONS(REGION_RUN) }
#undef REGIONS
#undef REGION_RUN
#undef REGION_COUNT
    for (int i = blockIdx.x * NTHR + tid; i < 32 * 1024 / 8; i += gridDim.x * NTHR) *(u32x4*)(WIN + (size_t)6880 * 1024 + (size_t)i * 8) = (u32x4){0u, 0u, 0u, 0u};
    if (blockIdx.x == gridDim.x - 1) { float* tab = (float*)(ws + WS_ROPE);
        for (int i = tid; i < 2048; i += NTHR) { const float inv = exp2f(-(float)(i & 15) * (13.287712379549449f / 16.f)); const float ang = (float)(i >> 4) * inv; tab[i] = cosf(ang); tab[2048 + i] = sinf(ang); } }
    __syncthreads();
    LAS float* sc = (LAS float*)lds;
    LAS float* red = (LAS float*)(lds + 20480);
    if ((int)blockIdx.x < NMODC / 32) {
        for (int i = tid; i < 5 * 1024; i += NTHR) { const float v = (i < 4096) ? a.in[1][i] : a.in[3][i - 4096]; sc[i] = siluf(v); }
        __syncthreads();
        const float* wm = a.in[4]; const float* bm = a.in[5]; float* mod = (float*)(ws + WS_MOD);
        for (int cb = blockIdx.x; cb < NMODC / 32; cb += gridDim.x) {
            const int cq4 = tid & 7, kg = tid >> 3, n = cb * 32 + cq4 * 4;
            f32x4 wv[16];
#pragma unroll
            for (int it = 0; it < 16; ++it) wv[it] = *(const f32x4*)(wm + (size_t)(kg + 64 * it) * NMODC + n);
            f32x4 acc[5];
#pragma unroll
            for (int r = 0; r < 5; ++r) acc[r] = (f32x4){0.f, 0.f, 0.f, 0.f};
#pragma unroll
            for (int it = 0; it < 16; ++it) {
#pragma unroll
                for (int r = 0; r < 5; ++r) acc[r] += wv[it] * sc[r * 1024 + kg + 64 * it]; }
#pragma unroll
            for (int r = 0; r < 5; ++r) *(LAS f32x4*)(red + (kg * 5 + r) * 32 + cq4 * 4) = acc[r];
            __syncthreads();
            if (tid < 160) { const int r = tid >> 5, c2 = tid & 31; float s = 0.f;
                for (int g = 0; g < 64; ++g) s += red[(g * 5 + r) * 32 + c2];
                mod[(size_t)r * NMODC + cb * 32 + c2] = s + bm[cb * 32 + c2]; }
            __syncthreads();
        }
    }
}
__device__ __forceinline__ void rms_mod_rows(const float* xl, const float* xc, int nrows, const float* nw, const float* mod, int shift_i, int scale_i, bf16_t* out, int lane, int wave) {
    const int gw = blockIdx.x * NWAVES + wave, NGW = gridDim.x * NWAVES;
    if (gw >= nrows) return;
    f32x4 wv[4];
#pragma unroll
    for (int j = 0; j < 4; ++j) wv[j] = *(const f32x4*)(nw + 4 * lane + 256 * j);
    f32x4 vn[4], vn2[4];
    { const float* xr = (gw < ML) ? xl + (size_t)gw * DM : xc + (size_t)(gw - ML) * DM;
#pragma unroll
      for (int j = 0; j < 4; ++j) vn[j] = *(const f32x4*)(xr + 4 * lane + 256 * j);
      const int m1 = (gw + NGW < nrows) ? gw + NGW : gw; const float* xr1 = (m1 < ML) ? xl + (size_t)m1 * DM : xc + (size_t)(m1 - ML) * DM;
#pragma unroll
      for (int j = 0; j < 4; ++j) vn2[j] = *(const f32x4*)(xr1 + 4 * lane + 256 * j); }
#pragma unroll 1
    for (int m = gw; m < nrows; m += NGW) {
        f32x4 v[4];
#pragma unroll
        for (int j = 0; j < 4; ++j) { v[j] = vn[j]; vn[j] = vn2[j]; }
        { const int mn = (m + 2 * NGW < nrows) ? m + 2 * NGW : m; const float* xr = (mn < ML) ? xl + (size_t)mn * DM : xc + (size_t)(mn - ML) * DM;
#pragma unroll
          for (int j = 0; j < 4; ++j) vn2[j] = *(const f32x4*)(xr + 4 * lane + 256 * j); }
        const float* mr = mod + (size_t)((m < ML) ? (m >> 13) : 4) * NMODC;
        f32x4 sh[4], scl[4];
#pragma unroll
        for (int j = 0; j < 4; ++j) { const int c = 4 * lane + 256 * j; sh[j] = *(const f32x4*)(mr + shift_i * 1024 + c); scl[j] = *(const f32x4*)(mr + scale_i * 1024 + c); }
        float s = 0.f;
#pragma unroll
        for (int j = 0; j < 4; ++j) s += (v[j].x * v[j].x + v[j].y * v[j].y) + (v[j].z * v[j].z + v[j].w * v[j].w);
        const float rs = rsqf(wave_sum(s) * (1.f / DM) + EPS);
#pragma unroll
        for (int j = 0; j < 4; ++j) { const int c = 4 * lane + 256 * j;
            const f32x4 y = (v[j] * rs * wv[j]) * (scl[j] + 1.0f) + sh[j];
            u32x2 o; o.x = pk2(y.x, y.y); o.y = pk2(y.z, y.w);
            *(u32x2*)(out + (size_t)m * DM + c) = o; }
    }
}
constexpr size_t WS_QCX = 430 * MiB, CTX_STRIDE = (size_t)1024 * 1024;
constexpr size_t WS_BEU = 440 * MiB;
constexpr size_t WS_DUMMY = 396 * MiB;
__device__ __forceinline__ void mla_prenorm(const Args& a, int lane, int wave, bool dry) {
    bf16_t* CQ = (bf16_t*)(a.ws + WS_CQ); bf16_t* CKV = (bf16_t*)(a.ws + WS_CKV); bf16_t* CQo = dry ? (bf16_t*)(a.ws + WS_DUMMY) : CQ; bf16_t* CKVo = dry ? (bf16_t*)(a.ws + WS_DUMMY + 26 * MiB) : CKV;
    const float* qn = a.in[13]; const float* kn = a.in[14];
    const int gw = blockIdx.x * NWAVES + wave, NGW = gridDim.x * NWAVES;
    const int lq = lane < 48 ? lane : 0, lk = lane < 32 ? lane : 0;
    float qw[8], kw[8];
    { const f32x4 a0 = *(const f32x4*)(qn + lq * 8), a1 = *(const f32x4*)(qn + lq * 8 + 4), b0 = *(const f32x4*)(kn + lk * 8), b1 = *(const f32x4*)(kn + lk * 8 + 4);
      qw[0] = a0.x; qw[1] = a0.y; qw[2] = a0.z; qw[3] = a0.w; qw[4] = a1.x; qw[5] = a1.y; qw[6] = a1.z; qw[7] = a1.w; kw[0] = b0.x; kw[1] = b0.y; kw[2] = b0.z; kw[3] = b0.w; kw[4] = b1.x; kw[5] = b1.y; kw[6] = b1.z; kw[7] = b1.w; }
#pragma unroll 1
    for (int m0 = gw; m0 < MT; m0 += 4 * NGW) {
        u32x4 wq[4], wk[4];
#pragma unroll
        for (int k = 0; k < 4; ++k) { const int m = (m0 + k * NGW < MT) ? m0 + k * NGW : m0; wq[k] = *(const u32x4*)(CQ + (size_t)m * 384 + lq * 8); wk[k] = *(const u32x4*)(CKV + (size_t)m * 256 + lk * 8); }
#pragma unroll
        for (int k = 0; k < 4; ++k) { const int m = m0 + k * NGW; const bool ok = m < MT;
            float f[8]; float s = 0.f; unpack8(wq[k], f);
#pragma unroll
            for (int i = 0; i < 8; ++i) s += f[i] * f[i];
            if (lane >= 48) s = 0.f;
            float rs = rsqf(wave_sum(s) * (1.f / 384.f) + EPS);
            if (ok && lane < 48) {
#pragma unroll
                for (int i = 0; i < 8; ++i) f[i] = f[i] * rs * qw[i];
                *(u32x4*)(CQo + (size_t)m * 384 + lane * 8) = pack8f(f); }
            s = 0.f; unpack8(wk[k], f);
#pragma unroll
            for (int i = 0; i < 8; ++i) s += f[i] * f[i];
            if (lane >= 32) s = 0.f;
            rs = rsqf(wave_sum(s) * (1.f / 256.f) + EPS);
            if (ok && lane < 32) {
#pragma unroll
                for (int i = 0; i < 8; ++i) f[i] = f[i] * rs * kw[i];
                *(u32x4*)(CKVo + (size_t)m * 256 + lane * 8) = pack8f(f); } }
    }
}
__device__ __forceinline__ void rope_norm8(float* f, float ss_half, const float* nrm8, int pc, bool act, bool do_rope, const float* c8, const float* s8) {
    const float rs = rsqf(ss_half * (1.f / 192.f) + EPS);
    float y[8];
#pragma unroll
    for (int i = 0; i < 8; ++i) y[i] = act ? f[i] * rs * nrm8[i] : 0.f;
    const int part = ((pc - 16) >> 1) & 1;
#pragma unroll
    for (int i = 0; i < 8; ++i) {
        const float other = __shfl_xor(y[i], 2);
        const float r = part ? (y[i] * c8[i] + other * s8[i]) : (y[i] * c8[i] - other * s8[i]);
        f[i] = (act && do_rope && pc >= 16) ? r : y[i];
    }
}
__device__ __forceinline__ void mla_finish(const Args& a, int lane, int wave, bool dry) {
    bf16_t* Q = (bf16_t*)a.out; const size_t dmask = dry ? (size_t)8191 : ~(size_t)0; bf16_t* Qo = dry ? (bf16_t*)(a.ws + WS_DUMMY) : Q; const bf16_t* KV = (const bf16_t*)(a.ws + WS_KVRAW); const bf16_t* KR = (const bf16_t*)(a.ws + WS_KR); bf16_t* KF = dry ? (bf16_t*)(a.ws + WS_DUMMY + 24 * MiB) : (bf16_t*)(a.ws + WS_KF);
    const float* qnm = a.in[17]; const float* knm = a.in[18]; const float* rtab = (const float*)(a.ws + WS_ROPE);
    const int gw = blockIdx.x * NWAVES + wave, NGW = gridDim.x * NWAVES;
    const int l32 = lane & 31, half = lane >> 5; const bool act = l32 < 24; const int pc = act ? l32 : 0, pcn = pc < 16 ? pc : 0, pcr = pc >= 16 ? pc - 16 : 0;
    float qw[8], kw[8];
    { const f32x4 a0 = *(const f32x4*)(qnm + pc * 8), a1 = *(const f32x4*)(qnm + pc * 8 + 4), b0 = *(const f32x4*)(knm + pc * 8), b1 = *(const f32x4*)(knm + pc * 8 + 4);
      qw[0] = a0.x; qw[1] = a0.y; qw[2] = a0.z; qw[3] = a0.w; qw[4] = a1.x; qw[5] = a1.y; qw[6] = a1.z; qw[7] = a1.w; kw[0] = b0.x; kw[1] = b0.y; kw[2] = b0.z; kw[3] = b0.w; kw[4] = b1.x; kw[5] = b1.y; kw[6] = b1.z; kw[7] = b1.w; }
#pragma unroll 1
    for (int m = gw; m < MT; m += NGW) {
        const bool lat = m < ML; const size_t mq = lat ? (size_t)m : 0;
        u32x4 wq[4], wkv[4];
#pragma unroll
        for (int hp = 0; hp < 4; ++hp) { const int h = 2 * hp + half; wq[hp] = *(const u32x4*)(Q + mq * 1536 + h * 192 + pc * 8); wkv[hp] = *(const u32x4*)(KV + (size_t)m * 2048 + h * 256 + pcn * 8); }
        const u32x4 krw = *(const u32x4*)(KR + (size_t)m * 64 + pcr * 8);
        const int t = m & (SEQ - 1); const int pos = (pcr >> 2) ? (t & 63) : (t >> 6); const float* tp = rtab + pos * 16 + (pc & 1) * 8;
        const f32x4 ca = *(const f32x4*)tp, cb = *(const f32x4*)(tp + 4), sa = *(const f32x4*)(tp + 2048), sb = *(const f32x4*)(tp + 2052);
        const bool rp = lat && act && pc >= 16;
        const float c8[8] = {rp ? ca.x : 1.f, rp ? ca.y : 1.f, rp ? ca.z : 1.f, rp ? ca.w : 1.f, rp ? cb.x : 1.f, rp ? cb.y : 1.f, rp ? cb.z : 1.f, rp ? cb.w : 1.f};
        const float s8[8] = {rp ? sa.x : 0.f, rp ? sa.y : 0.f, rp ? sa.z : 0.f, rp ? sa.w : 0.f, rp ? sb.x : 0.f, rp ? sb.y : 0.f, rp ? sb.z : 0.f, rp ? sb.w : 0.f};
#pragma unroll
        for (int hp = 0; hp < 4; ++hp) {
            const int h = 2 * hp + half;
            if (lat) {
                float f[8]; unpack8(wq[hp], f); float s = 0.f;
#pragma unroll
                for (int i = 0; i < 8; ++i) s += f[i] * f[i];
                if (!act) s = 0.f;
#pragma unroll
                for (int o = 1; o < 32; o <<= 1) s += __shfl_xor(s, o);
                rope_norm8(f, s, qw, pc, act, true, c8, s8);
                if (act) *(u32x4*)(Qo + ((size_t)m & dmask) * 1536 + h * 192 + pc * 8) = pack8f(f);
            }
            {
                float f[8]; unpack8(pc < 16 ? wkv[hp] : krw, f); float s = 0.f;
#pragma unroll
                for (int i = 0; i < 8; ++i) s += f[i] * f[i];
                if (!act) s = 0.f;
#pragma unroll
                for (int o = 1; o < 32; o <<= 1) s += __shfl_xor(s, o);
                rope_norm8(f, s, kw, pc, act, lat, c8, s8);
                if (act) *(u32x4*)(KF + ((size_t)m & dmask) * 1536 + h * 192 + pc * 8) = pack8f(f);
            }
        }
    }
}
__device__ __forceinline__ void halo_save(const Args& a, int tid) {
    const bf16_t* QKV = (const bf16_t*)(a.ws + WS_QR); bf16_t* HALO = (bf16_t*)(a.ws + WS_HALO);
    for (int idx = blockIdx.x * NTHR + tid; idx < (MT / 64) * 1536; idx += gridDim.x * NTHR) {
        const int g = idx / 1536, rem = idx % 1536, slot = rem / 384, arr = (rem % 384) >> 7, pcs = rem & 127;
        const int row = g * 64 + (slot < 2 ? slot : 60 + slot);
        *(u32x4*)(HALO + (((size_t)g * 4 + slot) * 3 + arr) * 1024 + pcs * 8) = *(const u32x4*)(QKV + (size_t)arr * QKV_STRIDE + (size_t)row * 1024 + pcs * 8);
    }
}
constexpr int PR_RAW = 0, PR_KN = 53312, PR_G = 70720, PR_GC = 87360, PR_CW = 88576;
#define PR_DECODE(u_, b_, h_, c_, nch_, rb_) do { if ((u_) < 4096) { b_ = (u_) >> 10; h_ = ((u_) >> 7) & 7; c_ = (u_) & 127; nch_ = 128; rb_ = b_ * SEQ + c_ * 64; } \
        else { const int v_ = (u_) - 4096; b_ = v_ >> 5; h_ = (v_ >> 2) & 7; c_ = v_ & 3; nch_ = 4; rb_ = ML + b_ * CTXL + c_ * 64; } } while (0)
__device__ __forceinline__ void gdn_prep(const Args& a, LAS unsigned char* lds, int tid, int lane, int wave, bool dry) {
    unsigned char* ws = a.ws;
    bf16_t* QKV = (bf16_t*)(ws + WS_QR); bf16_t* QCX = (bf16_t*)(ws + WS_QCX); const bf16_t* HALO = (const bf16_t*)(ws + WS_HALO); const float* BD = (const float*)(ws + WS_BD);
    float* GCU = (float*)(ws + WS_GCU); float* BTU = (float*)(ws + WS_BTU); float* BEU = (float*)(ws + WS_BEU); bf16_t* TL = (bf16_t*)a.out; bf16_t* TC = (bf16_t*)(ws + WS_TCTX);
    const float* convw = a.in[9]; const float* a_log = a.in[10]; const float* dt_bias = a.in[11];
    LAS bf16_t* raw = (LAS bf16_t*)(lds + PR_RAW); LAS bf16_t* kn = (LAS bf16_t*)(lds + PR_KN); LAS float* Gs = (LAS float*)(lds + PR_G);
    LAS float* gcs = (LAS float*)(lds + PR_GC); LAS float* bts = gcs + 128;
    const int r32 = lane & 31, hi = lane >> 5;
#define LBAR() do { asm volatile("s_waitcnt lgkmcnt(0)" ::: "memory"); __builtin_amdgcn_s_barrier(); asm volatile("" ::: "memory"); } while (0)
    u32x4 pr[7];
#define PR_LOADRAW(u_) do { int b_, h_, c_, nch_, rb_; PR_DECODE(u_, b_, h_, c_, nch_, rb_); const int g_ = rb_ >> 6; \
        const bf16_t* qkvb_ = (u_) < 4096 ? QKV : QCX - (size_t)ML * 1024; const size_t qst_ = (u_) < 4096 ? QKV_STRIDE : CTX_STRIDE; \
        _Pragma("unroll") for (int k_ = 0; k_ < 7; ++k_) { const int p_ = tid + 512 * k_; const int lr_ = p_ / 48, pc_ = p_ % 48, arr_ = pc_ >> 4, chp_ = pc_ & 15, i_ = lr_ - 2; \
            u32x4 w_ = {0u, 0u, 0u, 0u}; \
            if (p_ < 68 * 48) { \
                if (i_ >= 0 && i_ < 64) w_ = *(const u32x4*)(qkvb_ + (size_t)arr_ * qst_ + (size_t)(rb_ + i_) * 1024 + h_ * 128 + chp_ * 8); \
                else if (i_ < 0) { if (c_ > 0) w_ = *(const u32x4*)(HALO + (((size_t)(g_ - 1) * 4 + (2 + lr_)) * 3 + arr_) * 1024 + h_ * 128 + chp_ * 8); } \
                else { if (c_ < nch_ - 1) w_ = *(const u32x4*)(HALO + (((size_t)(g_ + 1) * 4 + (i_ - 64)) * 3 + arr_) * 1024 + h_ * 128 + chp_ * 8); } } \
            pr[k_] = w_; } } while (0)
    if ((int)blockIdx.x < 4224) PR_LOADRAW((int)blockIdx.x);
    LAS float* cws = (LAS float*)(lds + PR_CW);
    for (int i = tid; i < 5 * 3072 / 4; i += NTHR) *(LAS f32x4*)(cws + i * 4) = *(const f32x4*)(convw + i * 4);
#pragma unroll 1
    for (int u = blockIdx.x; u < 4224; u += gridDim.x) {
        int b, h, c, nch, rowbase; PR_DECODE(u, b, h, c, nch, rowbase); (void)c; (void)nch;
#pragma unroll
        for (int k = 0; k < 7; ++k) { const int p = tid + 512 * k, lr = p / 48, pc = p % 48; if (p < 68 * 48) *(LAS u32x4*)(raw + lr * 392 + pc * 8) = pr[k]; }
        LBAR();
        if (u + (int)gridDim.x < 4224) PR_LOADRAW(u + (int)gridDim.x);
        float bd_bl = 0.f, bd_dl = 0.f, bd_al = 0.f, bd_dt = 0.f;
        if (wave == 4 || wave == 5) { const int dir = wave - 4, dh = dir * 8 + h, ti = dir ? 63 - lane : lane; const size_t m = (size_t)rowbase + ti; bd_bl = BD[m * 32 + dh]; bd_dl = BD[m * 32 + 16 + dh]; bd_al = a_log[dh]; bd_dt = dt_bias[dh]; }
        { const int cgi = tid & 15, tsl = tid >> 4;
#pragma unroll
          for (int arr = 0; arr < 3; ++arr) {
            float wv[5][8];
#pragma unroll
            for (int tap = 0; tap < 5; ++tap) { const LAS float* wp = cws + tap * 3072 + arr * 1024 + h * 128 + cgi * 8; const f32x4 w0 = *(const LAS f32x4*)wp, w1 = *(const LAS f32x4*)(wp + 4);
                wv[tap][0] = w0.x; wv[tap][1] = w0.y; wv[tap][2] = w0.z; wv[tap][3] = w0.w; wv[tap][4] = w1.x; wv[tap][5] = w1.y; wv[tap][6] = w1.z; wv[tap][7] = w1.w; }
#pragma unroll
            for (int tt = 0; tt < 2; ++tt) {
                const int tok = tsl + 32 * tt;
                float acc[8];
#pragma unroll
                for (int e = 0; e < 8; ++e) acc[e] = 0.f;
#pragma unroll
                for (int tap = 0; tap < 5; ++tap) { const u32x4 w = *(const LAS u32x4*)(raw + (tok + tap) * 392 + arr * 128 + cgi * 8); float f[8]; unpack8(w, f);
#pragma unroll
                    for (int e = 0; e < 8; ++e) acc[e] += f[e] * wv[tap][e]; }
                float ss = 0.f;
#pragma unroll
                for (int e = 0; e < 8; ++e) { acc[e] = siluf(acc[e]); ss += acc[e] * acc[e]; }
                ss += __shfl_xor(ss, 1); ss += __shfl_xor(ss, 2); ss += __shfl_xor(ss, 4); ss += __shfl_xor(ss, 8);
                if (arr < 2) { const float rn = rsqf(ss + EPS);
#pragma unroll
                    for (int e = 0; e < 8; ++e) acc[e] *= rn; }
                const u32x4 o = pack8f(acc);
                if (dry) *(u32x4*)((bf16_t*)(ws + WS_DUMMY) + (size_t)arr * 8192 * 1024 + (size_t)((rowbase + tok) & 8191) * 1024 + h * 128 + cgi * 8) = o;
                else *(u32x4*)((u < 4096 ? QKV : QCX - (size_t)ML * 1024) + (size_t)arr * (u < 4096 ? QKV_STRIDE : CTX_STRIDE) + (size_t)(rowbase + tok) * 1024 + h * 128 + cgi * 8) = o;
                if (arr == 1) *(LAS u32x4*)(kn + tok * 136 + cgi * 8) = o;
            }
          } }
        LBAR();
        if (wave < 4) {
            const int it = wave >> 1, jt = wave & 1; f32x16 acc = {};
#pragma unroll
            for (int ks = 0; ks < 8; ++ks) { const bf16x8 av = *(const LAS bf16x8*)(kn + (it * 32 + r32) * 136 + ks * 16 + hi * 8), bv = *(const LAS bf16x8*)(kn + (jt * 32 + r32) * 136 + ks * 16 + hi * 8); acc = MFMA32(av, bv, acc); }
#pragma unroll
            for (int r = 0; r < 16; ++r) Gs[(it * 32 + crow(r, hi)) * 65 + jt * 32 + r32] = acc[r];
        } else if (wave < 6) {
            const int dir = wave - 4;
            const float beta = 1.f / (1.f + expf(-bd_bl));
            const float xx = bd_dl + bd_dt; const float sp = xx > 20.f ? xx : log1pf(expf(xx));
            float gcum = -expf(bd_al) * sp;
#pragma unroll
            for (int o = 1; o < 64; o <<= 1) { const float t = __shfl_up(gcum, o); if (lane >= o) gcum += t; }
            gcs[dir * 64 + lane] = gcum; bts[dir * 64 + lane] = beta;
            GCU[((size_t)u * 2 + dir) * 64 + lane] = gcum; BTU[((size_t)u * 2 + dir) * 64 + lane] = beta; BEU[((size_t)u * 2 + dir) * 64 + lane] = beta * expf(gcum);
        }
        LBAR();
        { bf16_t* Tg = (u < 4096 ? TL + (size_t)u * 8192 : TC + (size_t)(u - 4096) * 8192);
          const int e0 = tid * 16, dir = e0 >> 12, i = (e0 >> 6) & 63, j0 = e0 & 63, ti = dir ? 63 - i : i; const float bi = bts[dir * 64 + i], gi = gcs[dir * 64 + i];
          float v[16];
#pragma unroll
          for (int jj = 0; jj < 16; ++jj) { const int j = j0 + jj, tj = dir ? 63 - j : j; v[jj] = (j < i) ? bi * Gs[ti * 65 + tj] * __expf(fminf(gi - gcs[dir * 64 + j], 0.f)) : 0.f; }
          *(u32x4*)(Tg + e0) = pack8f(v); *(u32x4*)(Tg + e0 + 8) = pack8f(v + 8); }
    }
    __syncthreads();
    { LAS float* A = (LAS float*)(lds + wave * 16384);
      const int nun = (4224 - (int)blockIdx.x + (int)gridDim.x - 1) / (int)gridDim.x;
      u32x4 an[8];
      { const int it0 = wave < 2 * nun ? wave : 0; const int u0 = blockIdx.x + (it0 >> 1) * gridDim.x; const bf16_t* Tg0 = (u0 < 4096 ? TL + (size_t)u0 * 8192 : TC + (size_t)(u0 - 4096) * 8192) + (it0 & 1) * 4096;
#pragma unroll
        for (int k = 0; k < 8; ++k) an[k] = *(const u32x4*)(Tg0 + (lane + 64 * k) * 8); }
#pragma unroll 1
      for (int it = wave; it < 2 * nun; it += NWAVES) {
        const int u = blockIdx.x + (it >> 1) * gridDim.x, dir = it & 1;
        bf16_t* Tg = (u < 4096 ? TL + (size_t)u * 8192 : TC + (size_t)(u - 4096) * 8192) + dir * 4096;
#pragma unroll
        for (int k = 0; k < 8; ++k) { const int p = lane + 64 * k; float f[8]; unpack8(an[k], f);
            *(LAS f32x4*)(A + p * 8) = (f32x4){f[0], f[1], f[2], f[3]}; *(LAS f32x4*)(A + p * 8 + 4) = (f32x4){f[4], f[5], f[6], f[7]}; }
        { const int itn = (it + NWAVES < 2 * nun) ? it + NWAVES : it; const int un = blockIdx.x + (itn >> 1) * gridDim.x; const bf16_t* Tgn = (un < 4096 ? TL + (size_t)un * 8192 : TC + (size_t)(un - 4096) * 8192) + (itn & 1) * 4096;
#pragma unroll
          for (int k = 0; k < 8; ++k) an[k] = *(const u32x4*)(Tgn + (lane + 64 * k) * 8); }
        LDS_WAIT(); asm volatile("" ::: "memory");
        float t[64];
#pragma unroll
        for (int i = 0; i < 64; ++i) {
            float acc = (lane == i) ? 1.f : 0.f, ac1 = 0.f, ac2 = 0.f, ac3 = 0.f;
#pragma unroll
            for (int j4 = 0; j4 < (i + 3) / 4; ++j4) { const f32x4 a4 = *(const LAS f32x4*)(A + i * 64 + 4 * j4);
                if (4 * j4 + 0 < i) acc -= a4.x * t[4 * j4 + 0];
                if (4 * j4 + 1 < i) ac1 -= a4.y * t[4 * j4 + 1];
                if (4 * j4 + 2 < i) ac2 -= a4.z * t[4 * j4 + 2];
                if (4 * j4 + 3 < i) ac3 -= a4.w * t[4 * j4 + 3]; }
            acc = (acc + ac1) + (ac2 + ac3);
            t[i] = acc;
            Tg[i * 64 + lane] = f2bf(acc);
        }
        LDS_WAIT(); asm volatile("" ::: "memory");
      } }
    __syncthreads();
#undef LBAR
#undef PR_LOADRAW
}
constexpr int CH_QS = 0, CH_KS = 17408, CH_KT = 34816, CH_VT = 53248, CH_TP = 62464, CH_TPP = 71680, CH_W = 80896, CH_QK = 98304, CH_ST = 107520, CH_VN = 124928, CH_VND = 134144, CH_GC = 143360;
__device__ __forceinline__ void st4(LAS bf16_t* p, float a0, float a1, float a2, float a3) { u32x2 o; o.x = pk2(a0, a1); o.y = pk2(a2, a3); *(LAS u32x2*)p = o; }
__device__ __forceinline__ void gdn_chain(const Args& a, LAS unsigned char* lds, int tid, int lane, int wave) {
    if (blockIdx.x >= 128) return;
    unsigned char* ws = a.ws;
    const int w = (blockIdx.x & 7) * 16 + (blockIdx.x >> 3);
    const int b = w >> 5, h = (w >> 2) & 7, dir = (w >> 1) & 1, dvh = w & 1;
    const bf16_t* QR = (const bf16_t*)(ws + WS_QR); const bf16_t* KR = QR + QKV_STRIDE; const bf16_t* VR = QR + 2 * QKV_STRIDE;
    const float* GCU = (const float*)(ws + WS_GCU); const float* BTU = (const float*)(ws + WS_BTU); const bf16_t* TL = (const bf16_t*)a.out; const bf16_t* TC = (const bf16_t*)(ws + WS_TCTX);
    bf16_t* Od = dir ? (bf16_t*)a.out + (size_t)ML * 1024 : (bf16_t*)(ws + WS_OF);
    LAS bf16_t* qs = (LAS bf16_t*)(lds + CH_QS); LAS bf16_t* ks = (LAS bf16_t*)(lds + CH_KS); LAS bf16_t* kT = (LAS bf16_t*)(lds + CH_KT); LAS bf16_t* vT = (LAS bf16_t*)(lds + CH_VT);
    LAS bf16_t* Tp = (LAS bf16_t*)(lds + CH_TP); LAS bf16_t* Tpp = (LAS bf16_t*)(lds + CH_TPP); LAS bf16_t* wsm = (LAS bf16_t*)(lds + CH_W); LAS bf16_t* qk = (LAS bf16_t*)(lds + CH_QK);
    LAS bf16_t* ST = (LAS bf16_t*)(lds + CH_ST); LAS bf16_t* vn = (LAS bf16_t*)(lds + CH_VN); LAS bf16_t* vnd = (LAS bf16_t*)(lds + CH_VND); LAS float* gcs = (LAS float*)(lds + CH_GC);
    const int r32 = lane & 31, hi = lane >> 5;
    const float scale = 0.08838834764831845f;
    for (int i = tid; i < 64 * 136 / 8; i += NTHR) *(LAS u32x4*)(ST + i * 8) = (u32x4){0u, 0u, 0u, 0u};
    f32x16 Sacc = {};
    __syncthreads();
#define LBAR() do { asm volatile("s_waitcnt lgkmcnt(0)" ::: "memory"); __builtin_amdgcn_s_barrier(); asm volatile("" ::: "memory"); } while (0)
#define CH_UNIT(s_, u_, rb_, lat_) do { if ((s_) < 4) { const int cc_ = dir ? 3 - (s_) : (s_); u_ = 4096 + (b * 8 + h) * 4 + cc_; rb_ = ML + b * CTXL + cc_ * 64; lat_ = false; } \
        else { const int cc_ = dir ? 131 - (s_) : (s_) - 4; u_ = (b * 8 + h) * 128 + cc_; rb_ = b * SEQ + cc_ * 64; lat_ = true; } } while (0)
#define CH_LOAD(s_) do { int u_, rb_; bool lat_; CH_UNIT(s_, u_, rb_, lat_); \
        const bf16_t* Tg_ = (lat_ ? TL + (size_t)u_ * 8192 : TC + (size_t)(u_ - 4096) * 8192) + dir * 4096; \
        const float* gcu_ = GCU + ((size_t)u_ * 2 + dir) * 64; const float* btu_ = BTU + ((size_t)u_ * 2 + dir) * 64; \
        { const int ti_ = tid & 63, cg_ = tid >> 6; const size_t r0_ = (size_t)rb_ + (dir ? 63 - ti_ : ti_); \
          const bf16_t* qs_ = lat_ ? QR : (const bf16_t*)(ws + WS_QCX) - (size_t)ML * 1024; const size_t st_ = lat_ ? QKV_STRIDE : CTX_STRIDE; \
          pq0 = *(const u32x4*)(qs_ + r0_ * 1024 + h * 128 + cg_ * 8); pq1 = *(const u32x4*)(qs_ + r0_ * 1024 + h * 128 + 64 + cg_ * 8); \
          pk0 = *(const u32x4*)(qs_ + st_ + r0_ * 1024 + h * 128 + cg_ * 8); pk1 = *(const u32x4*)(qs_ + st_ + r0_ * 1024 + h * 128 + 64 + cg_ * 8); \
          pv0 = *(const u32x4*)(qs_ + 2 * st_ + r0_ * 1024 + h * 128 + dvh * 64 + cg_ * 8); } \
        { const int i_ = tid >> 3, j0_ = (tid & 7) * 8; pt0 = *(const u32x4*)(Tg_ + i_ * 64 + j0_); \
          pg0 = *(const f32x4*)(gcu_ + j0_); pg1 = *(const f32x4*)(gcu_ + j0_ + 4); pb0 = *(const f32x4*)(btu_ + j0_); pb1 = *(const f32x4*)(btu_ + j0_ + 4); } \
        pgc = gcu_[tid & 63]; pgl = gcu_[63]; } while (0)
#define CH_OSTORE(prow_) do { if (wave >= 4 && (prow_) >= 0) { const int it_ = (wave - 4) >> 1, dvt_ = (wave - 4) & 1; \
        _Pragma("unroll") for (int r = 0; r < 16; ++r) { const int i_ = it_ * 32 + crow(r, hi); const size_t row_ = (size_t)(prow_) + (dir ? 63 - i_ : i_); Od[row_ * 1024 + h * 128 + dvh * 64 + dvt_ * 32 + r32] = f2bf(oprev[r]); } } } while (0)
    u32x4 pq0, pq1, pk0, pk1, pv0, pt0; f32x4 pg0, pg1, pb0, pb1; float pgc, pgl; f32x16 oprev = {}; int prow = -1;
    CH_LOAD(0);
#pragma unroll 1
    for (int s = 0; s < 132; ++s) {
        int u, rowbase; bool lat; CH_UNIT(s, u, rowbase, lat); (void)u;
#pragma unroll
        for (int e2 = 0; e2 < 2; ++e2) { const int ti = tid & 63, cg = (tid >> 6) + 8 * e2;
            const u32x4 qv = e2 ? pq1 : pq0; *(LAS u32x4*)(qs + ti * 136 + cg * 8) = qv;
            const u32x4 kv = e2 ? pk1 : pk0; *(LAS u32x4*)(ks + ti * 136 + cg * 8) = kv;
            LAS bf16_t* kt = kT + (cg * 8) * 72 + ti;
            kt[0 * 72] = (bf16_t)(kv.x & 0xffffu); kt[1 * 72] = (bf16_t)(kv.x >> 16); kt[2 * 72] = (bf16_t)(kv.y & 0xffffu); kt[3 * 72] = (bf16_t)(kv.y >> 16);
            kt[4 * 72] = (bf16_t)(kv.z & 0xffffu); kt[5 * 72] = (bf16_t)(kv.z >> 16); kt[6 * 72] = (bf16_t)(kv.w & 0xffffu); kt[7 * 72] = (bf16_t)(kv.w >> 16); }
        { const int ti = tid & 63, cg = tid >> 6; const u32x4 vv = pv0;
            LAS bf16_t* vt = vT + (cg * 8) * 72 + ti;
            vt[0 * 72] = (bf16_t)(vv.x & 0xffffu); vt[1 * 72] = (bf16_t)(vv.x >> 16); vt[2 * 72] = (bf16_t)(vv.y & 0xffffu); vt[3 * 72] = (bf16_t)(vv.y >> 16);
            vt[4 * 72] = (bf16_t)(vv.z & 0xffffu); vt[5 * 72] = (bf16_t)(vv.z >> 16); vt[6 * 72] = (bf16_t)(vv.w & 0xffffu); vt[7 * 72] = (bf16_t)(vv.w >> 16); }
        { const int i = tid >> 3, j0 = (tid & 7) * 8; float tf[8], f1[8], f2[8]; unpack8(pt0, tf);
            const float gg[8] = {pg0.x, pg0.y, pg0.z, pg0.w, pg1.x, pg1.y, pg1.z, pg1.w}, bb[8] = {pb0.x, pb0.y, pb0.z, pb0.w, pb1.x, pb1.y, pb1.z, pb1.w};
#pragma unroll
            for (int e = 0; e < 8; ++e) { f2[e] = tf[e] * bb[e]; f1[e] = f2[e] * __expf(gg[e]); }
            *(LAS u32x4*)(Tp + i * 72 + j0) = pack8f(f1); *(LAS u32x4*)(Tpp + i * 72 + j0) = pack8f(f2); }
        if (tid < 64) gcs[tid] = pgc;
        float gc63 = pgl; asm volatile("" : "+v"(gc63));
        const float gl = __expf(gc63);
        LBAR();
        CH_OSTORE(prow);
        prow = lat ? rowbase : -1;
        if (s + 1 < 132) CH_LOAD(s + 1);
        f32x16 uacc = {};
        if (wave < 4) { const int it = wave >> 1, dvt = wave & 1;
{ bf16x8 fa_[4], fb_[4];
#pragma unroll
            for (int kk = 0; kk < 4; ++kk) { fa_[kk] = *(const LAS bf16x8*)(Tpp + (it * 32 + r32) * 72 + kk * 16 + hi * 8); fb_[kk] = *(const LAS bf16x8*)(vT + (dvt * 32 + r32) * 72 + kk * 16 + hi * 8); }
            __builtin_amdgcn_sched_barrier(0);
#pragma unroll
            for (int kk = 0; kk < 4; ++kk) uacc = MFMA32(fa_[kk], fb_[kk], uacc); } }
        { const int dkt = wave >> 1, it = wave & 1; f32x16 acc = {};
{ bf16x8 fa_[4], fb_[4];
#pragma unroll
            for (int kk = 0; kk < 4; ++kk) { fa_[kk] = *(const LAS bf16x8*)(kT + (dkt * 32 + r32) * 72 + kk * 16 + hi * 8); fb_[kk] = *(const LAS bf16x8*)(Tp + (it * 32 + r32) * 72 + kk * 16 + hi * 8); }
            __builtin_amdgcn_sched_barrier(0);
#pragma unroll
            for (int kk = 0; kk < 4; ++kk) acc = MFMA32(fa_[kk], fb_[kk], acc); }
#pragma unroll
            for (int g = 0; g < 4; ++g) st4(wsm + (it * 32 + r32) * 136 + dkt * 32 + 8 * g + 4 * hi, acc[4 * g], acc[4 * g + 1], acc[4 * g + 2], acc[4 * g + 3]); }
        if (wave >= 4) { const int it = (wave - 4) >> 1, jt = (wave - 4) & 1; f32x16 acc = {};
            if (jt <= it) {
{
#pragma unroll
                for (int kh = 0; kh < 2; ++kh) { bf16x8 fa_[4], fb_[4];
#pragma unroll
                for (int k4 = 0; k4 < 4; ++k4) { const int kk = kh * 4 + k4; fa_[k4] = *(const LAS bf16x8*)(ks + (jt * 32 + r32) * 136 + kk * 16 + hi * 8); fb_[k4] = *(const LAS bf16x8*)(qs + (it * 32 + r32) * 136 + kk * 16 + hi * 8); }
                __builtin_amdgcn_sched_barrier(0);
#pragma unroll
                for (int k4 = 0; k4 < 4; ++k4) acc = MFMA32(fa_[k4], fb_[k4], acc); } } }
            const int i = it * 32 + r32; const float gi = gcs[i];
#pragma unroll
            for (int g = 0; g < 4; ++g) { float v[4]; const int jb = jt * 32 + 8 * g + 4 * hi; const f32x4 gj = *(const LAS f32x4*)(gcs + jb);
                v[0] = (jb + 0 <= i) ? acc[4 * g + 0] * scale * __expf(fminf(gi - gj.x, 0.f)) : 0.f; v[1] = (jb + 1 <= i) ? acc[4 * g + 1] * scale * __expf(fminf(gi - gj.y, 0.f)) : 0.f;
                v[2] = (jb + 2 <= i) ? acc[4 * g + 2] * scale * __expf(fminf(gi - gj.z, 0.f)) : 0.f; v[3] = (jb + 3 <= i) ? acc[4 * g + 3] * scale * __expf(fminf(gi - gj.w, 0.f)) : 0.f;
                st4(qk + i * 72 + jb, v[0], v[1], v[2], v[3]); } }
        LBAR();
        f32x16 qS = {};
        if (wave < 4) { const int it = wave >> 1, dvt = wave & 1; f32x16 acc = {};
{
#pragma unroll
            for (int kh = 0; kh < 2; ++kh) { bf16x8 fa_[4], fb_[4];
#pragma unroll
            for (int k4 = 0; k4 < 4; ++k4) { const int kk = kh * 4 + k4; fa_[k4] = *(const LAS bf16x8*)(wsm + (it * 32 + r32) * 136 + kk * 16 + hi * 8); fb_[k4] = *(const LAS bf16x8*)(ST + (dvt * 32 + r32) * 136 + kk * 16 + hi * 8); }
            __builtin_amdgcn_sched_barrier(0);
#pragma unroll
            for (int k4 = 0; k4 < 4; ++k4) acc = MFMA32(fa_[k4], fb_[k4], acc); } }
#pragma unroll
            for (int g = 0; g < 4; ++g) { float v[4], vd[4]; const f32x4 gi4 = *(const LAS f32x4*)(gcs + it * 32 + 8 * g + 4 * hi); const float gia[4] = {gi4.x, gi4.y, gi4.z, gi4.w};
#pragma unroll
                for (int k = 0; k < 4; ++k) { v[k] = uacc[4 * g + k] - acc[4 * g + k]; vd[k] = v[k] * __expf(gc63 - gia[k]); }
                st4(vn + (dvt * 32 + r32) * 72 + it * 32 + 8 * g + 4 * hi, v[0], v[1], v[2], v[3]); st4(vnd + (dvt * 32 + r32) * 72 + it * 32 + 8 * g + 4 * hi, vd[0], vd[1], vd[2], vd[3]); }
        } else { const int it = (wave - 4) >> 1, dvt = (wave - 4) & 1;
{
#pragma unroll
            for (int kh = 0; kh < 2; ++kh) { bf16x8 fa_[4], fb_[4];
#pragma unroll
            for (int k4 = 0; k4 < 4; ++k4) { const int kk = kh * 4 + k4; fa_[k4] = *(const LAS bf16x8*)(qs + (it * 32 + r32) * 136 + kk * 16 + hi * 8); fb_[k4] = *(const LAS bf16x8*)(ST + (dvt * 32 + r32) * 136 + kk * 16 + hi * 8); }
            __builtin_amdgcn_sched_barrier(0);
#pragma unroll
            for (int k4 = 0; k4 < 4; ++k4) qS = MFMA32(fa_[k4], fb_[k4], qS); } }
#pragma unroll
            for (int g = 0; g < 4; ++g) { const f32x4 gi4 = *(const LAS f32x4*)(gcs + it * 32 + 8 * g + 4 * hi);
                qS[4 * g + 0] *= scale * __expf(gi4.x); qS[4 * g + 1] *= scale * __expf(gi4.y); qS[4 * g + 2] *= scale * __expf(gi4.z); qS[4 * g + 3] *= scale * __expf(gi4.w); } }
        LBAR();
        if (wave >= 4) { const int it = (wave - 4) >> 1, dvt = (wave - 4) & 1;
{ bf16x8 fa_[4], fb_[4];
#pragma unroll
            for (int kk = 0; kk < 4; ++kk) { fa_[kk] = *(const LAS bf16x8*)(qk + (it * 32 + r32) * 72 + kk * 16 + hi * 8); fb_[kk] = *(const LAS bf16x8*)(vn + (dvt * 32 + r32) * 72 + kk * 16 + hi * 8); }
            __builtin_amdgcn_sched_barrier(0);
#pragma unroll
            for (int kk = 0; kk < 4; ++kk) qS = MFMA32(fa_[kk], fb_[kk], qS); }
            oprev = qS; }
        { const int dkt = wave >> 1, dvt = wave & 1;
#pragma unroll
            for (int r = 0; r < 16; ++r) Sacc[r] *= gl;
{ bf16x8 fa_[4], fb_[4];
#pragma unroll
            for (int kk = 0; kk < 4; ++kk) { fa_[kk] = *(const LAS bf16x8*)(kT + (dkt * 32 + r32) * 72 + kk * 16 + hi * 8); fb_[kk] = *(const LAS bf16x8*)(vnd + (dvt * 32 + r32) * 72 + kk * 16 + hi * 8); }
            __builtin_amdgcn_sched_barrier(0);
#pragma unroll
            for (int kk = 0; kk < 4; ++kk) Sacc = MFMA32(fa_[kk], fb_[kk], Sacc); }
#pragma unroll
            for (int g = 0; g < 4; ++g) st4(ST + (dvt * 32 + r32) * 136 + dkt * 32 + 8 * g + 4 * hi, Sacc[4 * g], Sacc[4 * g + 1], Sacc[4 * g + 2], Sacc[4 * g + 3]); }
        LBAR();
    }
    CH_OSTORE(prow);
}
#undef CH_OSTORE
#undef LBAR
#undef CH_UNIT
#undef CH_LOAD
__device__ __forceinline__ void gdn_combine(const Args& a, int tid, bool dry) {
    bf16_t* OF = (bf16_t*)(a.ws + WS_OF); bf16_t* OFo = dry ? (bf16_t*)(a.ws + WS_DUMMY) : OF; const size_t dmask = dry ? (size_t)(16 * MiB - 1) : ~(size_t)0; const bf16_t* OB = (const bf16_t*)a.out + (size_t)ML * 1024; const bf16_t* Z = (const bf16_t*)(a.ws + WS_Z); const float* nw = a.in[12];
    const size_t total = (size_t)ML * 128, stride = (size_t)gridDim.x * NTHR;
    float nwv[8];
    { const int d0 = (tid & 15) * 8; const f32x4 n0 = *(const f32x4*)(nw + d0), n1 = *(const f32x4*)(nw + d0 + 4); nwv[0] = n0.x; nwv[1] = n0.y; nwv[2] = n0.z; nwv[3] = n0.w; nwv[4] = n1.x; nwv[5] = n1.y; nwv[6] = n1.z; nwv[7] = n1.w; }
#pragma unroll 1
    for (size_t idx0 = (size_t)blockIdx.x * NTHR + tid; idx0 < total; idx0 += 4 * stride) {
        u32x4 wf[4], wg[4], wz[4];
#pragma unroll
        for (int k = 0; k < 4; ++k) { const size_t idx = idx0 + k * stride, off = (idx < total ? idx : idx0) * 8; wf[k] = *(const u32x4*)(OF + off); wg[k] = *(const u32x4*)(OB + off); wz[k] = *(const u32x4*)(Z + off); }
#pragma unroll
        for (int k = 0; k < 4; ++k) { const size_t idx = idx0 + k * stride; const size_t off = idx * 8;
            float f[8], g[8], z[8]; unpack8(wf[k], f); unpack8(wg[k], g); unpack8(wz[k], z);
            float ss = 0.f;
#pragma unroll
            for (int e = 0; e < 8; ++e) { f[e] += g[e]; ss += f[e] * f[e]; }
            ss += __shfl_xor(ss, 1); ss += __shfl_xor(ss, 2); ss += __shfl_xor(ss, 4); ss += __shfl_xor(ss, 8);
            const float rs = rsqf(ss * (1.f / 128.f) + EPS);
#pragma unroll
            for (int e = 0; e < 8; ++e) f[e] = f[e] * rs * nwv[e] * siluf(z[e]);
            if (idx < total) *(u32x4*)(OFo + (off & dmask)) = pack8f(f); }
    }
}
constexpr int C2_QS = 0, C2_KT = 34816, C2_QK = 71680, C2_GC = 90112, C2_W = 90624, C2_UT = 108032, C2_KS = 112640, C2_VT = 130048, C2_TP = 134656, C2_TPP = 143872, C2_OL = 153088, C2_QL = 157696, C2_FAC = 162304, C2_END = 163328;
__device__ __forceinline__ bf16x8 rdfrag(const LAS bf16_t* p) { const u32x2 lo = *(const LAS u32x2*)p, h2 = *(const LAS u32x2*)(p + 8); const u32x4 w = {lo.x, lo.y, h2.x, h2.y}; return __builtin_bit_cast(bf16x8, w); }
#define PACKFRAG(x, s) __builtin_bit_cast(bf16x8, (u32x4){pk2((x)[8 * (s)], (x)[8 * (s) + 1]), pk2((x)[8 * (s) + 2], (x)[8 * (s) + 3]), pk2((x)[8 * (s) + 4], (x)[8 * (s) + 5]), pk2((x)[8 * (s) + 6], (x)[8 * (s) + 7])})
__device__ __forceinline__ void gdn_chain2(const Args& a, LAS unsigned char* lds, int tid, int lane, int wave) {
    unsigned char* ws = a.ws;
    const bf16_t* QR = (const bf16_t*)(ws + WS_QR); const bf16_t* KR = QR + QKV_STRIDE; const bf16_t* VR = QR + 2 * QKV_STRIDE;
    const float* GCU = (const float*)(ws + WS_GCU); const float* BTU = (const float*)(ws + WS_BTU); const float* BEU = (const float*)(ws + WS_BEU); const bf16_t* TL = (const bf16_t*)a.out; const bf16_t* TC = (const bf16_t*)(ws + WS_TCTX);
    LAS bf16_t* qs = (LAS bf16_t*)(lds + C2_QS); LAS bf16_t* kT = (LAS bf16_t*)(lds + C2_KT); LAS bf16_t* qk = (LAS bf16_t*)(lds + C2_QK); LAS float* gcs = (LAS float*)(lds + C2_GC);
    LAS bf16_t* wsm = (LAS bf16_t*)(lds + C2_W); LAS bf16_t* uT = (LAS bf16_t*)(lds + C2_UT); LAS bf16_t* ks = (LAS bf16_t*)(lds + C2_KS); LAS bf16_t* vT = (LAS bf16_t*)(lds + C2_VT);
    LAS bf16_t* Tp = (LAS bf16_t*)(lds + C2_TP); LAS bf16_t* Tpp = (LAS bf16_t*)(lds + C2_TPP); LAS bf16_t* oL = (LAS bf16_t*)(lds + C2_OL); LAS bf16_t* qL = (LAS bf16_t*)(lds + C2_QL); LAS float* fac = (LAS float*)(lds + C2_FAC);
    const int r32 = lane & 31, hi = lane >> 5, pw = wave - 1;
    const float scale = 0.08838834764831845f;
#define LBAR() do { asm volatile("s_waitcnt lgkmcnt(0)" ::: "memory"); __builtin_amdgcn_s_barrier(); asm volatile("" ::: "memory"); } while (0)
    if ((int)blockIdx.x < 256) {
    const int wi = blockIdx.x, w = (wi & 7) * 32 + (wi >> 3);
    const int b = w >> 6, h = (w >> 3) & 7, dir = (w >> 2) & 1, dvq = w & 3;
    bf16_t* Od = dir ? (bf16_t*)a.out + (size_t)ML * 1024 : (bf16_t*)(ws + WS_OF);
#define C2_UNIT(s_, u_, rb_, lat_) do { if ((s_) < 4) { const int cc_ = dir ? 3 - (s_) : (s_); u_ = 4096 + (b * 8 + h) * 4 + cc_; rb_ = ML + b * CTXL + cc_ * 64; lat_ = false; } \
        else { const int cc_ = dir ? 131 - (s_) : (s_) - 4; u_ = (b * 8 + h) * 128 + cc_; rb_ = b * SEQ + cc_ * 64; lat_ = true; } } while (0)
    u32x4 xq0, xq1, xq2, xk0, xk1, xk2, xv0, xt0, xt1; f32x4 xg0, xg1, xb0, xb1; float pgc;
#define C2_LOAD(s_) do { int u_, rb_; bool lat_; C2_UNIT(s_, u_, rb_, lat_); \
        const bf16_t* Tg_ = (lat_ ? TL + (size_t)u_ * 8192 : TC + (size_t)(u_ - 4096) * 8192) + dir * 4096; \
        const float* gcu_ = GCU + ((size_t)u_ * 2 + dir) * 64; const float* btu_ = BTU + ((size_t)u_ * 2 + dir) * 64; const float* beu_ = BEU + ((size_t)u_ * 2 + dir) * 64; \
        const bf16_t* QRs_ = lat_ ? QR : (const bf16_t*)(ws + WS_QCX) - (size_t)ML * 1024; const size_t st_ = lat_ ? QKV_STRIDE : CTX_STRIDE; \
        { const int ptid_ = tid - 64; const bf16_t* qb_ = QRs_ + (size_t)rb_ * 1024 + h * 128; \
          _Pragma("unroll") for (int m_ = 0; m_ < 3; ++m_) { const int p_ = ptid_ + 448 * m_, t_ = (p_ >> 4) & 63, c_ = p_ & 15; const u32x4 v_ = *(const u32x4*)(qb_ + (size_t)(dir ? 63 - t_ : t_) * 1024 + c_ * 8); if (m_ == 0) xq0 = v_; else if (m_ == 1) xq1 = v_; else xq2 = v_; } \
          xt0 = *(const u32x4*)(Tg_ + ptid_ * 8); xt1 = *(const u32x4*)(Tg_ + (448 + lane) * 8); \
          xg0 = *(const f32x4*)(beu_ + (lane & 7) * 8); xg1 = *(const f32x4*)(beu_ + (lane & 7) * 8 + 4); xb0 = *(const f32x4*)(btu_ + (lane & 7) * 8); xb1 = *(const f32x4*)(btu_ + (lane & 7) * 8 + 4); } \
        { const bf16_t* kb_ = QRs_ + st_ + (size_t)rb_ * 1024 + h * 128; const bf16_t* vb_ = QRs_ + 2 * st_ + (size_t)rb_ * 1024 + h * 128 + dvq * 32; \
          _Pragma("unroll") for (int m_ = 0; m_ < 3; ++m_) { const int blk_ = (pw + 7 * m_) & 15, t_ = (blk_ & 3) * 16 + (lane & 15), c_ = (blk_ >> 2) * 4 + (lane >> 4); \
              const u32x4 v_ = *(const u32x4*)(kb_ + (size_t)(dir ? 63 - t_ : t_) * 1024 + c_ * 8); if (m_ == 0) xk0 = v_; else if (m_ == 1) xk1 = v_; else xk2 = v_; } \
          { const int t_ = (pw & 3) * 16 + (lane & 15), c_ = lane >> 4; xv0 = *(const u32x4*)(vb_ + (size_t)(dir ? 63 - t_ : t_) * 1024 + c_ * 8); } } \
        pgc = gcu_[lane]; } while (0)
#ifdef EXP_DUPK
#define C2_DUPK(d, v) do { asm volatile("" ::: "memory"); C2_TR8(d, v); asm volatile("" ::: "memory"); } while (0)
#else
#define C2_DUPK(d, v) do {} while (0)
#endif
#define C2_TR8(dst_, v_) do { LAS bf16_t* d_ = (dst_); d_[0 * 72] = (bf16_t)((v_).x & 0xffffu); d_[1 * 72] = (bf16_t)((v_).x >> 16); d_[2 * 72] = (bf16_t)((v_).y & 0xffffu); d_[3 * 72] = (bf16_t)((v_).y >> 16); \
        d_[4 * 72] = (bf16_t)((v_).z & 0xffffu); d_[5 * 72] = (bf16_t)((v_).z >> 16); d_[6 * 72] = (bf16_t)((v_).w & 0xffffu); d_[7 * 72] = (bf16_t)((v_).w >> 16); } while (0)
#define C2_TPIECE(p_, tv_) do { const int i_ = (p_) >> 3, c8_ = (p_) & 7; float tf_[8], f1_[8], f2_[8]; unpack8(tv_, tf_); \
        const float gg_[8] = {xg0.x, xg0.y, xg0.z, xg0.w, xg1.x, xg1.y, xg1.z, xg1.w}, bb_[8] = {xb0.x, xb0.y, xb0.z, xb0.w, xb1.x, xb1.y, xb1.z, xb1.w}; \
        _Pragma("unroll") for (int e_ = 0; e_ < 8; ++e_) { f2_[e_] = tf_[e_] * bb_[e_]; f1_[e_] = tf_[e_] * gg_[e_]; } \
        *(LAS u32x4*)(Tp + i_ * 72 + c8_ * 8) = pack8f(f1_); *(LAS u32x4*)(Tpp + i_ * 72 + c8_ * 8) = pack8f(f2_); } while (0)
#define C2_STAGE_A(nb_) do { LAS bf16_t* qsn_ = qs + (nb_) * 8704; LAS bf16_t* kTn_ = kT + (nb_) * 9216; const int ptid_ = tid - 64; \
        { const int p0_ = ptid_, p1_ = ptid_ + 448, p2_ = ptid_ + 896; \
          *(LAS u32x4*)(qsn_ + (p0_ >> 4) * 136 + (p0_ & 15) * 8) = xq0; *(LAS u32x4*)(qsn_ + (p1_ >> 4) * 136 + (p1_ & 15) * 8) = xq1; if (p2_ < 1024) *(LAS u32x4*)(qsn_ + (p2_ >> 4) * 136 + (p2_ & 15) * 8) = xq2; } \
        { const int b0_ = pw, b1_ = pw + 7, b2_ = pw + 14, tl_ = lane & 15, cl_ = lane >> 4; \
          { const int t_ = (b0_ & 3) * 16 + tl_, c_ = (b0_ >> 2) * 4 + cl_; *(LAS u32x4*)(ks + t_ * 136 + c_ * 8) = xk0; C2_TR8(kTn_ + (c_ * 8) * 72 + t_, xk0); C2_DUPK(kTn_ + (c_ * 8) * 72 + t_, xk0); } \
          { const int t_ = (b1_ & 3) * 16 + tl_, c_ = (b1_ >> 2) * 4 + cl_; *(LAS u32x4*)(ks + t_ * 136 + c_ * 8) = xk1; C2_TR8(kTn_ + (c_ * 8) * 72 + t_, xk1); C2_DUPK(kTn_ + (c_ * 8) * 72 + t_, xk1); } \
          if (b2_ < 16) { const int t_ = (b2_ & 3) * 16 + tl_, c_ = (b2_ >> 2) * 4 + cl_; *(LAS u32x4*)(ks + t_ * 136 + c_ * 8) = xk2; C2_TR8(kTn_ + (c_ * 8) * 72 + t_, xk2); } \
          if (pw < 4) { const int t_ = pw * 16 + tl_; C2_TR8(vT + (cl_ * 8) * 72 + t_, xv0); } } \
        C2_TPIECE(ptid_, xt0); if (pw == 6) C2_TPIECE(448 + lane, xt1); \
        if (pw == 1) { gcs[(nb_) * 64 + lane] = pgc; const float g63_ = __shfl(pgc, 63); fac[(nb_) * 128 + lane] = scale * __expf(pgc); fac[(nb_) * 128 + 64 + lane] = __expf(g63_ - pgc); } } while (0)
#define C2_WJOB(jw_) do { const int dkt_ = (jw_) >> 1, it_ = (jw_) & 1; f32x16 acc_ = {}; bf16x8 fa_[4], fb_[4]; \
        _Pragma("unroll") for (int kk = 0; kk < 4; ++kk) { fa_[kk] = *(const LAS bf16x8*)(kTn + (dkt_ * 32 + r32) * 72 + kk * 16 + hi * 8); fb_[kk] = *(const LAS bf16x8*)(Tp + (it_ * 32 + r32) * 72 + kk * 16 + hi * 8); } \
        _Pragma("unroll") for (int kk = 0; kk < 4; ++kk) acc_ = MFMA32(fa_[kk], fb_[kk], acc_); \
        _Pragma("unroll") for (int g = 0; g < 4; ++g) st4(wsm + (it_ * 32 + r32) * 136 + dkt_ * 32 + 8 * g + 4 * hi, acc_[4 * g], acc_[4 * g + 1], acc_[4 * g + 2], acc_[4 * g + 3]); } while (0)
#define C2_UJOB(it_) do { f32x16 acc_ = {}; bf16x8 fa_[4], fb_[4]; \
        _Pragma("unroll") for (int kk = 0; kk < 4; ++kk) { fa_[kk] = *(const LAS bf16x8*)(Tpp + ((it_) * 32 + r32) * 72 + kk * 16 + hi * 8); fb_[kk] = *(const LAS bf16x8*)(vT + r32 * 72 + kk * 16 + hi * 8); } \
        _Pragma("unroll") for (int kk = 0; kk < 4; ++kk) acc_ = MFMA32(fa_[kk], fb_[kk], acc_); \
        _Pragma("unroll") for (int g = 0; g < 4; ++g) st4(uT + r32 * 72 + (it_) * 32 + 8 * g + 4 * hi, acc_[4 * g], acc_[4 * g + 1], acc_[4 * g + 2], acc_[4 * g + 3]); } while (0)
#define C2_QKJOB(it_, jt_) do { f32x16 acc_ = {}; \
        _Pragma("unroll") for (int kh = 0; kh < 2; ++kh) { bf16x8 fa_[4], fb_[4]; \
            _Pragma("unroll") for (int k4 = 0; k4 < 4; ++k4) { const int kk = kh * 4 + k4; fa_[k4] = *(const LAS bf16x8*)(ks + ((jt_) * 32 + r32) * 136 + kk * 16 + hi * 8); fb_[k4] = *(const LAS bf16x8*)(qsn + ((it_) * 32 + r32) * 136 + kk * 16 + hi * 8); } \
            _Pragma("unroll") for (int k4 = 0; k4 < 4; ++k4) acc_ = MFMA32(fa_[k4], fb_[k4], acc_); } \
        const int i_ = (it_) * 32 + r32; const float gi_ = gcn[i_]; \
        _Pragma("unroll") for (int g = 0; g < 4; ++g) { const int jb_ = (jt_) * 32 + 8 * g + 4 * hi; const f32x4 gj_ = *(const LAS f32x4*)(gcn + jb_); \
            const float v0_ = (jb_ + 0 <= i_) ? acc_[4 * g + 0] * scale * __expf(fminf(gi_ - gj_.x, 0.f)) : 0.f, v1_ = (jb_ + 1 <= i_) ? acc_[4 * g + 1] * scale * __expf(fminf(gi_ - gj_.y, 0.f)) : 0.f; \
            const float v2_ = (jb_ + 2 <= i_) ? acc_[4 * g + 2] * scale * __expf(fminf(gi_ - gj_.z, 0.f)) : 0.f, v3_ = (jb_ + 3 <= i_) ? acc_[4 * g + 3] * scale * __expf(fminf(gi_ - gj_.w, 0.f)) : 0.f; \
            st4(qkn + i_ * 72 + jb_, v0_, v1_, v2_, v3_); } } while (0)
#define C2_STAGE_B(nb_) do { const LAS bf16_t* qsn = qs + (nb_) * 8704; const LAS bf16_t* kTn = kT + (nb_) * 9216; LAS bf16_t* qkn = qk + (nb_) * 4608; const LAS float* gcn = gcs + (nb_) * 64; \
        if (pw == 0) { C2_QKJOB(0, 0); C2_UJOB(0); } else if (pw == 1) C2_QKJOB(1, 0); else if (pw == 2) C2_QKJOB(1, 1); \
        else if (pw == 3) { C2_UJOB(1); C2_WJOB(0); C2_WJOB(1); } else if (pw == 4) { C2_WJOB(2); C2_WJOB(3); } \
        else if (pw == 5) { C2_WJOB(4); C2_WJOB(5); } else { C2_WJOB(6); C2_WJOB(7); } } while (0)
#define C2_OSTORE(sprev_) do { int u_, rb_; bool lat_; C2_UNIT(sprev_, u_, rb_, lat_); (void)u_; \
        if (lat_ && pw < 4) { unsigned o_[8]; _Pragma("unroll") for (int e_ = 0; e_ < 8; ++e_) o_[e_] = oL[((sprev_) & 1) * 2304 + (pw * 8 + e_) * 72 + lane]; \
            u32x4 ow_; ow_.x = o_[0] | (o_[1] << 16); ow_.y = o_[2] | (o_[3] << 16); ow_.z = o_[4] | (o_[5] << 16); ow_.w = o_[6] | (o_[7] << 16); \
            *(u32x4*)(Od + ((size_t)rb_ + (dir ? 63 - lane : lane)) * 1024 + h * 128 + dvq * 32 + pw * 8) = ow_; } } while (0)
    if (wave == 0) {
    f32x16 S0 = {}, S1 = {}, S2 = {}, S3 = {};
    LBAR();
    LBAR();
#pragma unroll 1
    for (int s = 0; s < 132; ++s) {
        const int p = s & 1;
        int l136 = r32 * 136 + 4 * hi, l72 = r32 * 72 + 4 * hi, h4 = 4 * hi; asm volatile("" : "+v"(l136), "+v"(l72), "+v"(h4));
        const LAS bf16_t* qsp = qs + p * 8704 + l136; const LAS bf16_t* kTp = kT + p * 9216 + l72; const LAS bf16_t* qkp = qk + p * 4608 + l72; const LAS float* gcp = gcs + p * 64 + h4; const LAS float* gcp0 = gcs + p * 64; const LAS float* f1p = fac + p * 128 + h4; const LAS float* f2p = f1p + 64;
        const LAS bf16_t* wsl = wsm + l136; const LAS bf16_t* uTl = uT + l72; LAS bf16_t* oLl = oL + p * 2304 + l72;
        f32x16 vn0, vn1; bf16x8 vc00, vc01, vc10, vc11;
#ifdef EXP_SLEEP_C1
        __builtin_amdgcn_s_sleep(16);
#endif
        {
            const bf16x8 sb00 = PACKFRAG(S0, 0), sb01 = PACKFRAG(S0, 1), sb10 = PACKFRAG(S1, 0), sb11 = PACKFRAG(S1, 1), sb20 = PACKFRAG(S2, 0), sb21 = PACKFRAG(S2, 1), sb30 = PACKFRAG(S3, 0), sb31 = PACKFRAG(S3, 1);
#define C2_SDOT(acc_, base_) do { const LAS bf16_t* b_ = (base_); \
            acc_ = MFMA32(rdfrag(b_ + 0), sb00, acc_); acc_ = MFMA32(rdfrag(b_ + 16), sb01, acc_); acc_ = MFMA32(rdfrag(b_ + 32), sb10, acc_); acc_ = MFMA32(rdfrag(b_ + 48), sb11, acc_); \
            acc_ = MFMA32(rdfrag(b_ + 64), sb20, acc_); acc_ = MFMA32(rdfrag(b_ + 80), sb21, acc_); acc_ = MFMA32(rdfrag(b_ + 96), sb30, acc_); acc_ = MFMA32(rdfrag(b_ + 112), sb31, acc_); } while (0)
            { f32x16 acc = {}; C2_SDOT(acc, wsl);
#pragma unroll
              for (int g = 0; g < 4; ++g) { const u32x2 uu = *(const LAS u32x2*)(uTl + 0 * 32 + 8 * g);
                  vn0[4 * g + 0] = bflo(uu.x) - acc[4 * g + 0]; vn0[4 * g + 1] = bfhi(uu.x) - acc[4 * g + 1]; vn0[4 * g + 2] = bflo(uu.y) - acc[4 * g + 2]; vn0[4 * g + 3] = bfhi(uu.y) - acc[4 * g + 3]; } }
            { f32x16 acc = {}; C2_SDOT(acc, wsl + 32 * 136);
#pragma unroll
              for (int g = 0; g < 4; ++g) { const u32x2 uu = *(const LAS u32x2*)(uTl + 1 * 32 + 8 * g);
                  vn1[4 * g + 0] = bflo(uu.x) - acc[4 * g + 0]; vn1[4 * g + 1] = bfhi(uu.x) - acc[4 * g + 1]; vn1[4 * g + 2] = bflo(uu.y) - acc[4 * g + 2]; vn1[4 * g + 3] = bfhi(uu.y) - acc[4 * g + 3]; } }
            f32x16 qa = {}, qb = {};
            C2_SDOT(qa, qsp); C2_SDOT(qb, qsp + 32 * 136);
#pragma unroll
            for (int g = 0; g < 4; ++g) { const f32x4 ga = *(const LAS f32x4*)(f1p + 0 * 32 + 8 * g), gb = *(const LAS f32x4*)(f1p + 1 * 32 + 8 * g);
                qa[4 * g + 0] *= ga.x; qa[4 * g + 1] *= ga.y; qa[4 * g + 2] *= ga.z; qa[4 * g + 3] *= ga.w;
                qb[4 * g + 0] *= gb.x; qb[4 * g + 1] *= gb.y; qb[4 * g + 2] *= gb.z; qb[4 * g + 3] *= gb.w; }
            __builtin_amdgcn_sched_barrier(0);
            { const bf16x8 vb00 = PACKFRAG(vn0, 0), vb01 = PACKFRAG(vn0, 1), vb10 = PACKFRAG(vn1, 0), vb11 = PACKFRAG(vn1, 1);
              qa = MFMA32(rdfrag(qkp + 0), vb00, qa); qa = MFMA32(rdfrag(qkp + 16), vb01, qa);
              const LAS bf16_t* b_ = qkp + 32 * 72;
              qb = MFMA32(rdfrag(b_ + 0), vb00, qb); qb = MFMA32(rdfrag(b_ + 16), vb01, qb); qb = MFMA32(rdfrag(b_ + 32), vb10, qb); qb = MFMA32(rdfrag(b_ + 48), vb11, qb);
#pragma unroll
              for (int g = 0; g < 4; ++g) { st4(oLl + 0 * 32 + 8 * g, qa[4 * g], qa[4 * g + 1], qa[4 * g + 2], qa[4 * g + 3]); st4(oLl + 1 * 32 + 8 * g, qb[4 * g], qb[4 * g + 1], qb[4 * g + 2], qb[4 * g + 3]); } }
            __builtin_amdgcn_sched_barrier(0);
#pragma unroll
            for (int g = 0; g < 4; ++g) { const f32x4 ga = *(const LAS f32x4*)(f2p + 0 * 32 + 8 * g), gb = *(const LAS f32x4*)(f2p + 1 * 32 + 8 * g);
                vn0[4 * g + 0] *= ga.x; vn0[4 * g + 1] *= ga.y; vn0[4 * g + 2] *= ga.z; vn0[4 * g + 3] *= ga.w;
                vn1[4 * g + 0] *= gb.x; vn1[4 * g + 1] *= gb.y; vn1[4 * g + 2] *= gb.z; vn1[4 * g + 3] *= gb.w; }
            vc00 = PACKFRAG(vn0, 0); vc01 = PACKFRAG(vn0, 1); vc10 = PACKFRAG(vn1, 0); vc11 = PACKFRAG(vn1, 1);
#undef C2_SDOT
        }
        LBAR();
        {
#ifdef EXP_SLEEP_C2
            __builtin_amdgcn_s_sleep(16);
#endif
            const float gl = __expf(gcp0[63]);
            { bf16x8 ka[4][4];
#pragma unroll
              for (int t = 0; t < 4; ++t)
#pragma unroll
                for (int q = 0; q < 4; ++q) ka[t][q] = rdfrag(kTp + t * 32 * 72 + q * 16);
#pragma unroll
              for (int r = 0; r < 16; ++r) { S0[r] *= gl; S1[r] *= gl; S2[r] *= gl; S3[r] *= gl; }
              S0 = MFMA32(ka[0][0], vc00, S0); S1 = MFMA32(ka[1][0], vc00, S1); S2 = MFMA32(ka[2][0], vc00, S2); S3 = MFMA32(ka[3][0], vc00, S3);
              S0 = MFMA32(ka[0][1], vc01, S0); S1 = MFMA32(ka[1][1], vc01, S1); S2 = MFMA32(ka[2][1], vc01, S2); S3 = MFMA32(ka[3][1], vc01, S3);
              S0 = MFMA32(ka[0][2], vc10, S0); S1 = MFMA32(ka[1][2], vc10, S1); S2 = MFMA32(ka[2][2], vc10, S2); S3 = MFMA32(ka[3][2], vc10, S3);
              S0 = MFMA32(ka[0][3], vc11, S0); S1 = MFMA32(ka[1][3], vc11, S1); S2 = MFMA32(ka[2][3], vc11, S2); S3 = MFMA32(ka[3][3], vc11, S3); }
        }
        LBAR();
    }
    LBAR();
    } else {
    C2_LOAD(0); C2_STAGE_A(0);
    LBAR();
    C2_LOAD(1); C2_STAGE_B(0);
    LBAR();
#pragma unroll 1
    for (int s = 0; s < 132; ++s) {
        const int np = (s & 1) ^ 1;
#ifdef EXP_SLEEP_P1
        __builtin_amdgcn_s_sleep(16);
#endif
        if (s + 1 < 132) C2_STAGE_A(np);
        if (s > 0) C2_OSTORE(s - 1);
        if (s + 2 < 132) C2_LOAD(s + 2);
        LBAR();
        if (s + 1 < 132) C2_STAGE_B(np);
        LBAR();
    }
    C2_OSTORE(131);
    LBAR();
    }
    }
#undef LBAR
#undef C2_UNIT
#undef C2_LOAD
#undef C2_TR8
#undef C2_TPIECE
#undef C2_STAGE_A
#undef C2_WJOB
#undef C2_UJOB
#undef C2_QKJOB
#undef C2_STAGE_B
#undef C2_OSTORE
}
#define GAS __attribute__((address_space(1)))
#define XB_TMO      128
#define XB_XCNT(j)  (256  + 64 * (j))
#define XB_XSUB(j)  (1280 + 64 * (j))
#define XB_XGEN(j)  (2304 + 64 * (j))
#define XB_TOP      3328
#define XB_TOPGEN   3392
#define XCD_BAR_WORDS 3456
#define XB_SPIN_CAP (1u << 18)
#ifndef XB_SLEEP
#define XB_SLEEP 2
#endif

__device__ __forceinline__ unsigned xb_ld(unsigned* p)              { return __hip_atomic_load(p, __ATOMIC_RELAXED, __HIP_MEMORY_SCOPE_AGENT); }
__device__ __forceinline__ unsigned xb_add(unsigned* p, unsigned v) { return __hip_atomic_fetch_add(p, v, __ATOMIC_RELAXED, __HIP_MEMORY_SCOPE_AGENT); }
__device__ __forceinline__ unsigned xb_xcc_id() { return (unsigned)__builtin_amdgcn_s_getreg((3 << 11) | 20) & 0xFu; }
#define XB_SPIN(cond, bar) do { unsigned _sp = 0; while (cond) { __builtin_amdgcn_s_sleep(XB_SLEEP); \
    if ((++_sp & 255u) == 0u) { if (xb_ld(&(bar)[XB_TMO])) break; if (_sp > XB_SPIN_CAP) { atomicAdd(&(bar)[XB_TMO], 1u); break; } } } } while (0)

struct XcdBarrier {
    unsigned* bar; unsigned x;
    volatile LAS unsigned* st;
};

__device__ __forceinline__ XcdBarrier xcd_barrier_post(unsigned* bar, volatile LAS unsigned* st) {
    XcdBarrier b; b.bar = bar; b.x = xb_xcc_id(); b.st = st;
    if (threadIdx.x == 0) (void)xb_add(&bar[XB_XCNT(b.x)], 1u);
    return b;
}
__device__ __forceinline__ void xcd_barrier_complete(unsigned* bar, unsigned x, unsigned& nloc, unsigned& nx) {
    const unsigned G = gridDim.x * gridDim.y * gridDim.z;
    unsigned sum, cnt, mine, sp = 0u;
    for (;;) {
        sum = 0u; cnt = 0u; mine = 0u;
#pragma unroll
        for (unsigned j = 0; j < 16; ++j) { const unsigned c = xb_ld(&bar[XB_XCNT(j)]); sum += c; cnt += (c > 0u) ? 1u : 0u; mine = (j == x) ? c : mine; }
        if (sum == G) break;
        __builtin_amdgcn_s_sleep(XB_SLEEP);
        if ((++sp & 255u) == 0u) { if (xb_ld(&bar[XB_TMO])) break; if (sp > XB_SPIN_CAP) { atomicAdd(&bar[XB_TMO], 1u); break; } }
    }
    nloc = mine > 0u ? mine : 1u; nx = cnt > 0u ? cnt : 1u;
}

__device__ __forceinline__ void xcd_barrier(const XcdBarrier& b) {
    asm volatile("s_waitcnt vmcnt(0)" ::: "memory");
    __syncthreads();
    if (threadIdx.x == 0) {
        unsigned* bar = b.bar;
        __builtin_amdgcn_s_waitcnt(0);
        unsigned nloc = b.st[0], nx = b.st[1];
        if (nloc == 0u) { xcd_barrier_complete(bar, b.x, nloc, nx); b.st[0] = nloc; b.st[1] = nx; }
        const unsigned old = xb_add(&bar[XB_XSUB(b.x)], 1u);
        const unsigned gen = old / nloc;
        if (old + 1u == (gen + 1u) * nloc) {
            __builtin_amdgcn_fence(__ATOMIC_RELEASE, "agent");
            asm volatile("s_waitcnt vmcnt(0)" ::: "memory");
            const unsigned og = xb_add(&bar[XB_TOP], 1u);
            const unsigned tg = og / nx;
            if (og + 1u == (tg + 1u) * nx) xb_add(&bar[XB_TOPGEN], 1u);
            else XB_SPIN(xb_ld(&bar[XB_TOPGEN]) == tg, bar);
            __builtin_amdgcn_fence(__ATOMIC_ACQUIRE, "agent");
            xb_add(&bar[XB_XGEN(b.x)], 1u);
            asm volatile("s_waitcnt vmcnt(0)" ::: "memory");
        } else {
            XB_SPIN(xb_ld(&bar[XB_XGEN(b.x)]) == gen, bar);
            __builtin_amdgcn_fence(__ATOMIC_ACQUIRE, "agent");
            asm volatile("s_waitcnt vmcnt(0)" ::: "memory");
        }
    }
    __syncthreads();
}

constexpr int N_PHASES = 19;
#ifndef CHAIN_FN
#define CHAIN_FN gdn_chain2
#endif
#ifndef REP_ATT
#define REP_ATT 1
#endif
#ifndef REP_CHAIN
#define REP_CHAIN 1
#endif
#ifndef REP_SMALL
#define REP_SMALL 0
#endif
#ifndef REP_PREP
#define REP_PREP 0
#endif
#ifndef REP_GEMM
#define REP_GEMM 1
#endif
#ifndef MK_PER_PHASE
#define MK_PER_PHASE 0
#endif
struct PassASched { int G, c;
    __device__ __forceinline__ bool next(int i, pg8::Unit& u) const {
        if (G == 256) {
            const int x = c & 7, q = (c >> 3) + 32 * i, np = (x < 4) ? 17 : 16;
            if (q < 3 * np) { u.pm = x + 8 * (q / 3); u.pn = 24 + q % 3; return true; }
            const int r = q - 3 * np; if (r < 6) { const int e = x * 6 + r; u.pm = 128 + (e & 3); u.pn = e >> 2; return true; }
            return false; }
        const int L = i * G + c;
        if (L < 396) { u.pm = L % 132; u.pn = 24 + L / 132; return true; }
        if (L < 444) { const int L2 = L - 396; u.pm = 128 + (L2 & 3); u.pn = L2 >> 2; return true; }
        return false; }
    __device__ __forceinline__ void a_ready(const pg8::Unit&) const {}
    __device__ __forceinline__ void done(const pg8::Unit&) const {} };
template <class Op> __device__ __forceinline__ void run_gemm(LAS unsigned char* lds, const bf16_t* A, const bf16_t* Bt, int M, int N, int K, const Op& op) {
    pg8::Gemm g{A, Bt, M, N, K}; pg8::StaticOrder S; S.init(M, N, (int)gridDim.x, (int)blockIdx.x);
    pg8::EpiOp<Op> E{op};
    pg8::gemm_phase<pg8::EpiOp<Op>, pg8::StaticOrder, true, true>(lds, g, S, E);
}
__global__ void __launch_bounds__(NTHR, 2) fwd_kernel(Args a) {
    extern __shared__ __attribute__((aligned(16))) unsigned char lds_[];
    LAS unsigned char* lds = (LAS unsigned char*)lds_;
    cg::grid_group grid = cg::this_grid();
    const int tid = threadIdx.x, lane = tid & 63, wave = __builtin_amdgcn_readfirstlane(tid >> 6);
    const int lo = a.ph_lo, hi = a.ph_hi;
    volatile LAS unsigned* bst = (volatile LAS unsigned*)(lds + LDS_BYTES - 64);
    if (tid < 2) bst[tid] = 0u;
    __syncthreads();
    XcdBarrier xbar = xcd_barrier_post((unsigned*)(a.ws + WS_CTL) + CW_BAR, bst);
    unsigned char* ws = a.ws;
    const float* x = a.in[0]; const float* ctx = a.in[2]; float* out = a.out;
    float* MOD = (float*)(ws + WS_MOD);
    bf16_t* WIN = (bf16_t*)(ws + WS_WIN); bf16_t* H = (bf16_t*)(ws + WS_H);
#ifndef PH_MASK
#define PH_MASK 0x7ffff
#endif
#define IN(k) ((((PH_MASK) >> (k)) & 1) && lo <= (k) && (k) < hi)
#define SEAM(k) do { if (IN(k) && IN((k) + 1)) xcd_barrier(xbar); } while (0)
#ifdef REP_SYNC
    for (int i_ = 0; i_ < REP_SYNC; ++i_) grid.sync();
#endif
    if (hi > 1000) grid.sync();
    if (IN(0)) { if (REP_SMALL) { p0_prologue(a, lds, tid, lane, wave); __syncthreads(); } p0_prologue(a, lds, tid, lane, wave); }
    SEAM(0);
#ifdef REP_XSYNC
    for (int i_ = 0; i_ < REP_XSYNC; ++i_) xcd_barrier(xbar);
#endif
    if (IN(1)) { if (REP_SMALL) rms_mod_rows(x, ctx, MT, a.in[6], MOD, 0, 1, H, lane, wave); rms_mod_rows(x, ctx, MT, a.in[6], MOD, 0, 1, H, lane, wave); }
    SEAM(1);
    if (IN(2)) { pg8::OpRouteA ra{(bf16_t*)(ws + WS_CQ), (bf16_t*)(ws + WS_CKV), (bf16_t*)(ws + WS_KR), (float*)(ws + WS_BD)};
        pg8::OpPassA2 op{ra, (bf16_t*)(ws + WS_QCX), CTX_STRIDE, (bf16_t*)(ws + WS_HALO), ML};
        pg8::Gemm g{H, WIN, MT, 6912, 1024}; PassASched S{(int)gridDim.x, (int)blockIdx.x}; pg8::EpiOp<pg8::OpPassA2> E{op};
        pg8::gemm_phase<pg8::EpiOp<pg8::OpPassA2>, PassASched, true, true>(lds, g, S, E); }
    SEAM(2);
    if (IN(3)) { if (REP_SMALL) mla_prenorm(a, lane, wave, true); mla_prenorm(a, lane, wave, false); }
    SEAM(3);
    if (IN(4)) { { pg8::OpPlain op{(bf16_t*)out, 1536}; run_gemm(lds, (const bf16_t*)(ws + WS_CQ), (const bf16_t*)(ws + WS_WUQ), ML, 1536, 384, op); }
                 { pg8::OpPlain op{(bf16_t*)(ws + WS_KVRAW), 2048}; run_gemm(lds, (const bf16_t*)(ws + WS_CKV), (const bf16_t*)(ws + WS_WUKV), MT, 2048, 256, op); } }
    SEAM(4);
    if (IN(5)) { if (REP_SMALL) mla_finish(a, lane, wave, true); mla_finish(a, lane, wave, false); }
    SEAM(5);
    if (IN(6)) {
        const att::bf16* Q = (const att::bf16*)out; const att::bf16* KF = (const att::bf16*)(ws + WS_KF); const att::bf16* KV = (const att::bf16*)(ws + WS_KVRAW); att::bf16* O = (att::bf16*)(ws + WS_O);
        const int G = gridDim.x, bx = blockIdx.x, vcu = (G % 8 == 0) ? (bx % 8) * (G / 8) + bx / 8 : bx;
        for (int rep = 0; rep < REP_ATT; ++rep)
        for (int n = vcu; n < 1024; n += G) {
            const int bh = ((n & 255) >> 5) * 4 + (n >> 8), qb = n & 31, b = bh >> 3, h = bh & 7;
            att::attn_dense_body<ATT_SDEPTH>(Q + ((size_t)b * SEQ + qb * 256) * 1536 + h * 192,
                KF + ((size_t)ML + b * CTXL) * 1536 + h * 192, KF + ((size_t)b * SEQ) * 1536 + h * 192,
                KV + ((size_t)ML + b * CTXL) * 2048 + h * 256 + 128, KV + ((size_t)b * SEQ) * 2048 + h * 256 + 128,
                O + ((size_t)b * SEQ + qb * 256) * 1024 + h * 128, CTXL + SEQ, (char*)lds_);
        }
    }
    SEAM(6);
#ifndef REP_GDNPRE
#define REP_GDNPRE 1
#endif
    for (int rep_ = 0; rep_ < REP_GDNPRE; ++rep_) {
    if (rep_ > 0) grid.sync();
    if (IN(7)) { pg8::OpSplit3 op{(bf16_t*)(ws + WS_QR), QKV_STRIDE, (bf16_t*)(ws + WS_HALO)}; run_gemm(lds, H, WIN, ML, 3072, 1024, op); }
    SEAM(7);
    if (IN(9)) { if (REP_PREP) { gdn_prep(a, lds, tid, lane, wave, true); __syncthreads(); } gdn_prep(a, lds, tid, lane, wave, false); }
    SEAM(9);
    }
    if (IN(10)) for (int rep = 0; rep < REP_CHAIN; ++rep) { if (gridDim.x >= 256) gdn_chain2(a, lds, tid, lane, wave); else gdn_chain(a, lds, tid, lane, wave); __syncthreads(); }
    SEAM(10);
    if (IN(11)) { pg8::OpZGate op{(bf16_t*)(ws + WS_Z), (bf16_t*)(ws + WS_SG)}; run_gemm(lds, H, WIN + (size_t)3072 * 1024, ML, 3072, 1024, op); }
    SEAM(11);
    if (IN(12)) { if (REP_SMALL) gdn_combine(a, tid, true); gdn_combine(a, tid, false); }
    SEAM(12);
    if (IN(13)) { pg8::OpGate<false> op{(bf16_t*)(ws + WS_Y), (const bf16_t*)(ws + WS_SG), 0}; run_gemm(lds, (const bf16_t*)(ws + WS_OF), (const bf16_t*)(ws + WS_WBG), ML, 1024, 1024, op); }
    if (IN(14)) { pg8::OpGate<true> op{(bf16_t*)(ws + WS_Y), (const bf16_t*)(ws + WS_SG), 1024}; run_gemm(lds, (const bf16_t*)(ws + WS_O), (const bf16_t*)(ws + WS_WBM), ML, 1024, 1024, op); }
    SEAM(14);
    if (IN(15)) { pg8::OpResid op{x, out, MOD + 2 * 1024}; run_gemm(lds, (const bf16_t*)(ws + WS_Y), (const bf16_t*)(ws + WS_WOUT), ML, 1024, 1024, op); }
    SEAM(15);
    if (IN(16)) { if (REP_SMALL) rms_mod_rows(out, out, ML, a.in[7], MOD, 3, 4, H, lane, wave); rms_mod_rows(out, out, ML, a.in[7], MOD, 3, 4, H, lane, wave); }
    SEAM(16);
    if (IN(17)) { pg8::OpRelu2 op{(bf16_t*)(ws + WS_HID)}; run_gemm(lds, H, (const bf16_t*)(ws + WS_WM1), ML, 4096, 1024, op);
#ifdef REP_P17
        __syncthreads(); run_gemm(lds, H, (const bf16_t*)(ws + WS_WM1), ML, 4096, 1024, op);
#endif
    }
    SEAM(17);
    if (IN(18)) { pg8::OpResid op{out, out, MOD + 5 * 1024}; run_gemm(lds, (const bf16_t*)(ws + WS_HID), (const bf16_t*)(ws + WS_WM2), ML, 1024, 4096, op); }
#undef IN
#undef SEAM
}

extern "C" void kernel_launch(void* const* d_in, const int* in_sizes, int n_in, void* d_out, int out_size, void* d_ws, size_t ws_size, hipStream_t stream) {
    static int grid = 0;
    if (grid == 0) {
        if (n_in != 24 || in_sizes[0] != ML * DM || out_size != ML * DM || ws_size < WS_END) { fprintf(stderr, "kernel_launch: unexpected shapes (n_in %d, in0 %d, out %d, ws %zu)\n", n_in, n_in > 0 ? in_sizes[0] : -1, out_size, ws_size); grid = -1; return; }
        int dev = 0, cus = 0, per_cu = 0;
        if (hipGetDevice(&dev) != hipSuccess || hipDeviceGetAttribute(&cus, hipDeviceAttributeMultiprocessorCount, dev) != hipSuccess) { grid = -1; return; }
        if (hipFuncSetAttribute((const void*)fwd_kernel, hipFuncAttributeMaxDynamicSharedMemorySize, LDS_BYTES) != hipSuccess) { fprintf(stderr, "kernel_launch: hipFuncSetAttribute failed\n"); grid = -1; return; }
        if (hipOccupancyMaxActiveBlocksPerMultiprocessor(&per_cu, (const void*)fwd_kernel, NTHR, LDS_BYTES) != hipSuccess || per_cu < 1) { fprintf(stderr, "kernel_launch: occupancy query says %d\n", per_cu); per_cu = 1; }
        (void)hipGetLastError();
        grid = cus;
    }
    if (grid < 0) return;
    if (hipMemsetAsync((char*)d_ws + WS_CTL, 0, CTL_ZERO_BYTES, stream) != hipSuccess) { fprintf(stderr, "kernel_launch: hipMemsetAsync failed\n"); return; }
    Args a{};
    for (int i = 0; i < 24; ++i) a.in[i] = (const float*)d_in[i];
    a.out = (float*)d_out; a.ws = (unsigned char*)d_ws;
#if MK_PER_PHASE
    for (int p = 0; p < N_PHASES; ++p) { a.ph_lo = p; a.ph_hi = p + 1; hipLaunchKernelGGL(fwd_kernel, dim3(grid), dim3(NTHR), LDS_BYTES, stream, a); }
#else
    a.ph_lo = 0; a.ph_hi = N_PHASES;
    void* args[] = {&a};
    const hipError_t e = hipLaunchCooperativeKernel((const void*)fwd_kernel, dim3(grid), dim3(NTHR), args, LDS_BYTES, stream);
    if (e != hipSuccess) fprintf(stderr, "kernel_launch: cooperative launch failed: %s (grid %d)\n", hipGetErrorString(e), grid);
#endif
}
```

```cpp
#include <hip/hip_runtime.h>
#include <hip/hip_bf16.h>
#include <hip/hip_cooperative_groups.h>
#include <cstdio>
#include <cstdint>
namespace cg = cooperative_groups;
#ifndef ATT_SDEPTH
#define ATT_SDEPTH 1
#endif
namespace pg8 {
#define PG8_LAS __attribute__((address_space(3)))
typedef unsigned short bf16_t;
typedef short bf16x8 __attribute__((ext_vector_type(8)));
typedef float f32x4 __attribute__((ext_vector_type(4)));
typedef unsigned u32x4 __attribute__((ext_vector_type(4)));
constexpr int BM = 256, BK = 64, HALF = 128, HTB = HALF * BK * 2  , STAGE_BYTES = 8 * HTB, NXCD = 8, WGM = 8;

__host__ __device__ __forceinline__ int lds_byte(int r, int c) { const int st = (r >> 4) * 2 + (c >> 5), rr = r & 15, cc = c & 31, ob = rr * 64 + cc * 2; return st * 1024 + (ob ^ (((ob >> 9) & 1) << 5)); }
__host__ __device__ __forceinline__ void stage_rc(int b, int& R, int& C) { const int st = b / 1024, sb = b % 1024, swz = sb ^ (((sb >> 9) & 1) << 5); R = (st >> 1) * 16 + swz / 64; C = (st & 1) * 32 + (swz % 64) / 2; }
__host__ __device__ __forceinline__ int perm32(int rho) { const int n = rho >> 4, i = rho & 15; return 8 * (i >> 2) + 4 * n + (i & 3); }

struct Unit { int pm, pn; };
struct Gemm { const bf16_t* A; const bf16_t* Bt; int M, N, K; };

struct StaticOrder {
    int nM, nN, nwg, G, c;
    __host__ __device__ void init(int M, int N, int G_, int c_) { nM = M / BM; nN = N / BM; nwg = nM * nN; G = G_; c = c_; }
    __host__ __device__ bool next(int i, Unit& u) const {
        const long L = (long)i * G + c; if (L >= nwg) return false;
        int wgid = (int)L; { const int q = nwg / NXCD, r = nwg % NXCD, xcd = wgid % NXCD, off = wgid / NXCD; wgid = (xcd < r ? xcd * (q + 1) : r * (q + 1) + (xcd - r) * q) + off; }
        const int nig = WGM * nN, gid = wgid / nig, fm = gid * WGM, gsz = (nM - fm) < WGM ? (nM - fm) : WGM;
        u.pm = fm + ((wgid % nig) % gsz); u.pn = (wgid % nig) / gsz; return true;
    }
    __device__ __forceinline__ void a_ready(const Unit&) const {}
    __device__ __forceinline__ void done(const Unit&) const {}
};

__device__ __forceinline__ unsigned cvt_pk_s(float lo, float hi) { typedef float f2 __attribute__((ext_vector_type(2))); typedef __bf16 b2 __attribute__((ext_vector_type(2))); f2 v = {lo, hi}; b2 b = __builtin_convertvector(v, b2); return __builtin_bit_cast(unsigned, b); }
__device__ __forceinline__ u32x4 pack8(f32x4 v0, f32x4 v1) { u32x4 w; w.x = cvt_pk_s(v0[0], v0[1]); w.y = cvt_pk_s(v0[2], v0[3]); w.z = cvt_pk_s(v1[0], v1[1]); w.w = cvt_pk_s(v1[2], v1[3]); return w; }
__device__ __forceinline__ float bflo(unsigned w) { return __builtin_bit_cast(float, w << 16); }
__device__ __forceinline__ float bfhi(unsigned w) { return __builtin_bit_cast(float, w & 0xffff0000u); }
template <class Op> struct EpiOp {
    static constexpr bool PERM = true, AFTER_DRAIN = false;
    Op op;
    __device__ __forceinline__ void operator()(const f32x4 (&acc)[2][2][4][2], const Unit& u, int wr, int wc, int fr, int fq) const {
        const int row0 = u.pm * BM + wr * 64 + fr, col0 = u.pn * BM + wc * 32 + 8 * fq;
#pragma unroll
        for (int ai = 0; ai < 2; ++ai)
#pragma unroll
            for (int m = 0; m < 4; ++m)
#pragma unroll
                for (int bj = 0; bj < 2; ++bj) op(row0 + ai * HALF + m * 16, col0 + bj * HALF, acc[ai][bj][m][0], acc[ai][bj][m][1]);
    }
};
struct OpPlain { static constexpr bool IDEMP = true; bf16_t* O; int ldc;
    __device__ __forceinline__ void operator()(int row, int col, f32x4 v0, f32x4 v1) const { *(u32x4*)(O + (size_t)row * ldc + col) = pack8(v0, v1); } };
struct OpRouteA { static constexpr bool IDEMP = true; bf16_t* cq; bf16_t* ckv; bf16_t* kr; float* bd;
    __device__ __forceinline__ void operator()(int row, int col, f32x4 v0, f32x4 v1) const {
        if (col < 384) *(u32x4*)(cq + (size_t)row * 384 + col) = pack8(v0, v1);
        else if (col < 640) *(u32x4*)(ckv + (size_t)row * 256 + (col - 384)) = pack8(v0, v1);
        else if (col < 704) *(u32x4*)(kr + (size_t)row * 64 + (col - 640)) = pack8(v0, v1);
        else if (col < 736) { float* p = bd + (size_t)row * 32 + (col - 704); *(f32x4*)p = v0; *(f32x4*)(p + 4) = v1; }
    } };
struct OpSplit3 { static constexpr bool IDEMP = true; bf16_t* O; size_t stride; bf16_t* halo;
    __device__ __forceinline__ void operator()(int row, int col, f32x4 v0, f32x4 v1) const { const int t = col >> 10; const u32x4 w = pack8(v0, v1);
        *(u32x4*)(O + (size_t)t * stride + (size_t)row * 1024 + (col & 1023)) = w;
        const int r6 = row & 63;
        if (r6 < 2 || r6 >= 62) { const int slot = r6 < 2 ? r6 : r6 - 60; *(u32x4*)(halo + (((size_t)(row >> 6) * 4 + slot) * 3 + t) * 1024 + (col & 1023)) = w; } } };
struct OpPassA2 { static constexpr bool IDEMP = true; OpRouteA ra; bf16_t* qcx; size_t cst; bf16_t* halo; int row_ctx0;
    __device__ __forceinline__ void operator()(int row, int col, f32x4 v0, f32x4 v1) const {
        if (col >= 6144) { ra(row, col - 6144, v0, v1); return; }
        const int t = col >> 10; const u32x4 w = pack8(v0, v1);
        *(u32x4*)(qcx + (size_t)t * cst + (size_t)(row - row_ctx0) * 1024 + (col & 1023)) = w;
        const int r6 = row & 63;
        if (r6 < 2 || r6 >= 62) { const int slot = r6 < 2 ? r6 : r6 - 60; *(u32x4*)(halo + (((size_t)(row >> 6) * 4 + slot) * 3 + t) * 1024 + (col & 1023)) = w; } } };
struct OpZGate { static constexpr bool IDEMP = true; bf16_t* Z; bf16_t* SG;
    __device__ __forceinline__ void operator()(int row, int col, f32x4 v0, f32x4 v1) const {
        if (col < 1024) { *(u32x4*)(Z + (size_t)row * 1024 + col) = pack8(v0, v1); return; }
#pragma unroll
        for (int i = 0; i < 4; ++i) { v0[i] = __builtin_amdgcn_rcpf(1.f + __expf(-v0[i])); v1[i] = __builtin_amdgcn_rcpf(1.f + __expf(-v1[i])); }
        *(u32x4*)(SG + (size_t)row * 2048 + (col - 1024)) = pack8(v0, v1);
    } };
template <bool ADD> struct OpGate { static constexpr bool IDEMP = !ADD; bf16_t* Y; const bf16_t* SG; int goff;
    __device__ __forceinline__ void operator()(int row, int col, f32x4 v0, f32x4 v1) const {
        const u32x4 g = *(const u32x4*)(SG + (size_t)row * 2048 + goff + col);
        f32x4 a0 = {bflo(g.x), bfhi(g.x), bflo(g.y), bfhi(g.y)}, a1 = {bflo(g.z), bfhi(g.z), bflo(g.w), bfhi(g.w)};
        v0 = v0 * a0; v1 = v1 * a1;
        bf16_t* yp = Y + (size_t)row * 1024 + col;
        if (ADD) { const u32x4 y = *(const u32x4*)yp; f32x4 y0 = {bflo(y.x), bfhi(y.x), bflo(y.y), bfhi(y.y)}, y1 = {bflo(y.z), bfhi(y.z), bflo(y.w), bfhi(y.w)}; v0 = v0 + y0; v1 = v1 + y1; }
        *(u32x4*)yp = pack8(v0, v1);
    } };
struct OpResid { static constexpr bool IDEMP = false; const float* base; float* out; const float* gate;
    __device__ __forceinline__ void operator()(int row, int col, f32x4 v0, f32x4 v1) const {
        const float* gp = gate + (size_t)(row >> 13) * 6144 + col; const size_t off = (size_t)row * 1024 + col;
        const f32x4 g0 = *(const f32x4*)gp, g1 = *(const f32x4*)(gp + 4), b0 = *(const f32x4*)(base + off), b1 = *(const f32x4*)(base + off + 4);
        *(f32x4*)(out + off) = b0 + g0 * v0; *(f32x4*)(out + off + 4) = b1 + g1 * v1;
    } };
struct OpRelu2 { static constexpr bool IDEMP = true; bf16_t* O;
    __device__ __forceinline__ void operator()(int row, int col, f32x4 v0, f32x4 v1) const {
#pragma unroll
        for (int i = 0; i < 4; ++i) { const float a = fmaxf(v0[i], 0.f), b = fmaxf(v1[i], 0.f); v0[i] = a * a; v1[i] = b * b; }
        *(u32x4*)(O + (size_t)row * 4096 + col) = pack8(v0, v1);
    } };
template <class Epi, class Sched, bool ALIGN_EPI = false, bool SP2 = false>
__device__ __forceinline__ void gemm_phase(PG8_LAS unsigned char* lds, const Gemm g, const Sched& S, const Epi& E) {
    int tid_ = threadIdx.x; asm volatile("" : "+v"(tid_));
    const int tid = tid_, wid = __builtin_amdgcn_readfirstlane(tid >> 6), lane = tid & 63, wr = wid >> 2, wc = wid & 3, fr = lane & 15, fq = lane >> 4;
    const int K = g.K, nt = K / BK;
    unsigned voffA[2], voffB[2];
#pragma unroll
    for (int i = 0; i < 2; ++i) { int R, C; stage_rc(tid * 16 + i * 8192, R, C); const int Rb = Epi::PERM ? ((R & ~31) + perm32(R & 31)) : R;
        voffA[i] = (unsigned)(R * K + C) * 2u; voffB[i] = (unsigned)(Rb * K + C) * 2u; }
    const size_t kstep = (size_t)(BK * 2);
    const size_t hstep = (size_t)HALF * K * 2;
    const size_t tstep = 2 * hstep;
    const unsigned ldsw = (unsigned)wid * 1024u;
    const int aoff = lds_byte(wr * 64 + fr, fq * 8), boff = lds_byte(wc * 32 + fr, fq * 8);
#define PG8_SA(b, h) (((b) * 2 + (h)) * HTB)
#define PG8_SB(b, h) ((4 + (b) * 2 + (h)) * HTB)
#define PG8_STAGE(bufoff, gbase, voff) do { _Pragma("unroll") for (int _i = 0; _i < 2; ++_i) \
        __builtin_amdgcn_global_load_lds((const unsigned*)((const char*)(gbase) + (voff)[_i]), (PG8_LAS unsigned*)(lds + (bufoff) + ldsw + _i * 8192), 16, 0, 0); } while (0)
#define PG8_LDA(dst, b, h) do { _Pragma("unroll") for (int m = 0; m < 4; ++m) _Pragma("unroll") for (int k = 0; k < 2; ++k) dst[m][k] = *(const PG8_LAS bf16x8*)(lds + PG8_SA(b, h) + aoff + m * 2048 + k * 1024); } while (0)
#define PG8_LDB(dst, b, h) do { _Pragma("unroll") for (int n = 0; n < 2; ++n) _Pragma("unroll") for (int k = 0; k < 2; ++k) dst[n][k] = *(const PG8_LAS bf16x8*)(lds + PG8_SB(b, h) + boff + n * 2048 + k * 1024); } while (0)
#define PG8_MMA(ai, bj, At, Bt) do { __builtin_amdgcn_s_setprio(1); _Pragma("unroll") for (int m = 0; m < 4; ++m) _Pragma("unroll") for (int n = 0; n < 2; ++n) _Pragma("unroll") for (int k = 0; k < 2; ++k) \
        acc[ai][bj][m][n] = __builtin_amdgcn_mfma_f32_16x16x32_bf16(Bt[n][k], At[m][k], acc[ai][bj][m][n], 0, 0, 0); __builtin_amdgcn_s_setprio(0); } while (0)
#define PG8_WAIT_V(n) asm volatile("s_waitcnt vmcnt(" #n ")" ::: "memory")
#define PG8_WAIT_L(n) asm volatile("s_waitcnt lgkmcnt(" #n ")" ::: "memory")
#define PG8_BAR __builtin_amdgcn_s_barrier()
#define PG8_SCHED __builtin_amdgcn_sched_barrier(0)
    Unit cur, nxt; int ui = 0;
    if (!S.next(0, cur)) return;
    f32x4 acc[2][2][4][2];
#pragma unroll
    for (int a = 0; a < 2; ++a)
#pragma unroll
        for (int b = 0; b < 2; ++b)
#pragma unroll
            for (int m = 0; m < 4; ++m)
#pragma unroll
                for (int n = 0; n < 2; ++n) acc[a][b][m][n] = (f32x4){0.f, 0.f, 0.f, 0.f};
    bf16x8 At[4][2], B0[2][2], B1[2][2];
    const char* cA = (const char*)g.A + (size_t)cur.pm * tstep; const char* cB = (const char*)g.Bt + (size_t)cur.pn * tstep;
    S.a_ready(cur);
    if constexpr (SP2) {
        PG8_STAGE(PG8_SB(0, 0), cB, voffB); PG8_STAGE(PG8_SB(0, 1), cB + hstep, voffB); PG8_STAGE(PG8_SA(0, 0), cA, voffA); PG8_STAGE(PG8_SA(0, 1), cA + hstep, voffA);
        if (wr == 1) PG8_BAR;
        PG8_WAIT_V(2); PG8_BAR;
        PG8_STAGE(PG8_SB(1, 0), cB + kstep, voffB); PG8_STAGE(PG8_SA(1, 0), cA + kstep, voffA); PG8_STAGE(PG8_SB(1, 1), cB + hstep + kstep, voffB);
        PG8_WAIT_V(6); PG8_BAR;
    } else {
        PG8_STAGE(PG8_SB(0, 0), cB, voffB); PG8_STAGE(PG8_SA(0, 0), cA, voffA); PG8_STAGE(PG8_SB(0, 1), cB + hstep, voffB); PG8_STAGE(PG8_SA(0, 1), cA + hstep, voffA);
        if (wr == 1) PG8_BAR;
        PG8_WAIT_V(4); PG8_BAR;
        PG8_STAGE(PG8_SB(1, 0), cB + kstep, voffB); PG8_STAGE(PG8_SA(1, 0), cA + kstep, voffA); PG8_STAGE(PG8_SB(1, 1), cB + hstep + kstep, voffB);
        PG8_WAIT_V(6); PG8_BAR;
    }
    for (;;) {
        const bool has_next = S.next(ui + 1, nxt);
        const char* nA = has_next ? (const char*)g.A + (size_t)nxt.pm * tstep : cA; const char* nB = has_next ? (const char*)g.Bt + (size_t)nxt.pn * tstep : cB;
        for (int t = 0; t < nt; t += 2) {
            const bool last = (t == nt - 2);
            const char* a1 = cA + (size_t)(t + 1) * kstep;
            const char* a2 = last ? nA : cA + (size_t)(t + 2) * kstep; const char* b2 = last ? nB : cB + (size_t)(t + 2) * kstep;
            const char* a3 = a2 + kstep; const char* b3 = b2 + kstep;
            if (last && has_next) S.a_ready(nxt);
            if constexpr (SP2) {
            PG8_LDB(B0, 0, 0); PG8_LDB(B1, 0, 1); PG8_SCHED; PG8_LDA(At, 0, 0); PG8_STAGE(PG8_SA(1, 1), a1 + hstep, voffA);
            PG8_WAIT_V(8); PG8_WAIT_L(0); PG8_BAR; PG8_MMA(0, 0, At, B0); PG8_MMA(0, 1, At, B1); PG8_BAR; PG8_SCHED;
            PG8_LDA(At, 0, 1); PG8_STAGE(PG8_SB(0, 0), b2, voffB); PG8_STAGE(PG8_SB(0, 1), b2 + hstep, voffB); PG8_STAGE(PG8_SA(0, 0), a2, voffA);
            PG8_WAIT_V(8); PG8_WAIT_L(0); PG8_BAR; PG8_MMA(1, 0, At, B0); PG8_MMA(1, 1, At, B1); PG8_BAR; PG8_SCHED;
            PG8_LDB(B0, 1, 0); PG8_LDB(B1, 1, 1); PG8_SCHED; PG8_LDA(At, 1, 0); PG8_STAGE(PG8_SA(0, 1), a2 + hstep, voffA);
            PG8_WAIT_V(8); PG8_WAIT_L(0); PG8_BAR; PG8_MMA(0, 0, At, B0); PG8_MMA(0, 1, At, B1); PG8_BAR; PG8_SCHED;
            PG8_LDA(At, 1, 1); PG8_STAGE(PG8_SB(1, 0), b3, voffB); PG8_STAGE(PG8_SB(1, 1), b3 + hstep, voffB); PG8_STAGE(PG8_SA(1, 0), a3, voffA);
            PG8_WAIT_V(8); PG8_WAIT_L(0); PG8_BAR; PG8_MMA(1, 0, At, B0); PG8_MMA(1, 1, At, B1); PG8_BAR; PG8_SCHED;
            } else {
            PG8_LDB(B0, 0, 0); PG8_SCHED; PG8_LDA(At, 0, 0); PG8_STAGE(PG8_SA(1, 1), a1 + hstep, voffA);
            PG8_WAIT_L(8); PG8_BAR; PG8_WAIT_L(0); PG8_MMA(0, 0, At, B0); PG8_BAR; PG8_SCHED;
            PG8_LDB(B1, 0, 1); PG8_STAGE(PG8_SB(0, 0), b2, voffB);
            PG8_BAR; PG8_WAIT_L(0); PG8_MMA(0, 1, At, B1); PG8_BAR;
            PG8_LDA(At, 0, 1); PG8_STAGE(PG8_SA(0, 0), a2, voffA);
            PG8_BAR; PG8_WAIT_L(0); PG8_MMA(1, 0, At, B0); PG8_BAR; PG8_SCHED;
            PG8_STAGE(PG8_SB(0, 1), b2 + hstep, voffB);
            PG8_WAIT_V(6); PG8_BAR; PG8_MMA(1, 1, At, B1); PG8_BAR;
            PG8_LDB(B0, 1, 0); PG8_SCHED; PG8_LDA(At, 1, 0); PG8_STAGE(PG8_SA(0, 1), a2 + hstep, voffA);
            PG8_WAIT_L(8); PG8_BAR; PG8_WAIT_L(0); PG8_MMA(0, 0, At, B0); PG8_BAR; PG8_SCHED;
            PG8_LDB(B1, 1, 1); PG8_STAGE(PG8_SB(1, 0), b3, voffB);
            PG8_BAR; PG8_WAIT_L(0); PG8_MMA(0, 1, At, B1); PG8_BAR;
            PG8_LDA(At, 1, 1); PG8_STAGE(PG8_SA(1, 0), a3, voffA);
            PG8_BAR; PG8_WAIT_L(0); PG8_MMA(1, 0, At, B0); PG8_BAR; PG8_SCHED;
            PG8_STAGE(PG8_SB(1, 1), b3 + hstep, voffB);
            PG8_WAIT_V(6); PG8_BAR; PG8_MMA(1, 1, At, B1); PG8_BAR;
            }
        }
        if constexpr (ALIGN_EPI) { if (wr == 0) PG8_BAR; }
        if constexpr (!Epi::AFTER_DRAIN) { E(acc, cur, wr, wc, fr, fq); S.done(cur); }
        if (!has_next) break;
#pragma unroll
        for (int a = 0; a < 2; ++a)
#pragma unroll
            for (int b = 0; b < 2; ++b)
#pragma unroll
                for (int m = 0; m < 4; ++m)
#pragma unroll
                    for (int n = 0; n < 2; ++n) acc[a][b][m][n] = (f32x4){0.f, 0.f, 0.f, 0.f};
        cur = nxt; cA = nA; cB = nB; ++ui;
        if constexpr (ALIGN_EPI) { if (wr == 1) PG8_BAR; }
    }
    PG8_WAIT_V(0);
    if constexpr (!ALIGN_EPI) { if (wr == 0) PG8_BAR; }
    PG8_BAR;
    if constexpr (Epi::AFTER_DRAIN) { E.fused(acc, cur, wr, wc, fr, fq, lds, wid, lane); S.done(cur); }
#undef PG8_SA
#undef PG8_SB
#undef PG8_STAGE
#undef PG8_LDA
#undef PG8_LDB
#undef PG8_MMA
#undef PG8_WAIT_V
#undef PG8_WAIT_L
#undef PG8_BAR
#undef PG8_SCHED
}
}
namespace att {
using bf16 = __hip_bfloat16;
constexpr int DQK = 192, DV = 128, NW = 8, QBLK = 32, KVBLK = 64;
constexpr float SCALE = 0.07216878364870323f;
constexpr float THR = 8.f;
constexpr int LDQ = 1536, LDK = 1536, LDV = 2048, LDO = 1024;
#ifndef QKT_GRP
#define QKT_GRP 4
#endif
#ifndef ATT_NQREG
#define ATT_NQREG 12
#endif
constexpr int NQREG = ATT_NQREG;
constexpr int SHM_V = KVBLK * DV * 2, SHM_K = KVBLK * 400, SHM_QL = 2 * SHM_V + 2 * SHM_K + NW * 64 * 4, SHM_ATTN = SHM_QL + NW * (12 - NQREG) * 1024;
using bf16x8 = __attribute__((ext_vector_type(8))) short;
using s16x4  = __attribute__((ext_vector_type(4))) short;
using f32x16 = __attribute__((ext_vector_type(16))) float;
using u32x4  = __attribute__((ext_vector_type(4))) unsigned;
#define KSWZ(row, colB) ((row) * 400 + (colB))
#define SBAR() __builtin_amdgcn_sched_barrier(0)
__device__ __forceinline__ int crow(int r, int hi) { return (r & 3) + 8 * (r >> 2) + 4 * hi; }
__device__ __forceinline__ unsigned cvtpk(float lo, float hi) { unsigned r; asm volatile("v_cvt_pk_bf16_f32 %0, %1, %2" : "=v"(r) : "v"(lo), "v"(hi)); return r; }
__device__ __forceinline__ void partialSM(f32x16& p0, f32x16& p1, float& m_reg, float& mn, float& alpha) {
  constexpr float C = SCALE * 1.4426950408889634f;
  float pmax = p0[0]; for (int r = 1; r < 16; ++r) pmax = fmaxf(pmax, p0[r]); for (int r = 0; r < 16; ++r) pmax = fmaxf(pmax, p1[r]);
  { auto rr = __builtin_amdgcn_permlane32_swap(__float_as_uint(pmax), __float_as_uint(pmax), false, false);
    pmax = fmaxf(__uint_as_float(rr[0]), __uint_as_float(rr[1])); }
  if (__builtin_expect(__all(pmax - m_reg <= THR / SCALE), 1)) { mn = m_reg; alpha = 1.f; }
  else { mn = fmaxf(m_reg, pmax); alpha = __builtin_amdgcn_exp2f((m_reg - mn) * C); m_reg = mn; }
  float mnC = -mn * C;
  for (int r = 0; r < 16; ++r) p0[r] = fmaf(p0[r], C, mnC); for (int r = 0; r < 16; ++r) p1[r] = fmaf(p1[r], C, mnC);
  for (int r = 0; r < 16; ++r) p0[r] = __builtin_amdgcn_exp2f(p0[r]);
}
__device__ __forceinline__ void finishSM(f32x16& p0, f32x16& p1, float alpha, float& l_reg, bf16x8& pa0, bf16x8& pa1, bf16x8& pa2, bf16x8& pa3) {
  for (int r = 0; r < 16; ++r) p1[r] = __builtin_amdgcn_exp2f(p1[r]);
  float ps = 0; for (int r = 0; r < 16; ++r) ps += p0[r]; for (int r = 0; r < 16; ++r) ps += p1[r];
  { auto rr = __builtin_amdgcn_permlane32_swap(__float_as_uint(ps), __float_as_uint(ps), false, false);
    ps = __uint_as_float(rr[0]) + __uint_as_float(rr[1]); }
  l_reg = l_reg * alpha + ps;
#define PK4(P, BASE, OUT) do { unsigned a0 = cvtpk(P[BASE + 0], P[BASE + 1]), a1 = cvtpk(P[BASE + 2], P[BASE + 3]);   \
    unsigned b0 = cvtpk(P[BASE + 4], P[BASE + 5]), b1 = cvtpk(P[BASE + 6], P[BASE + 7]);                              \
    auto r0 = __builtin_amdgcn_permlane32_swap(a0, b0, false, false); auto r1 = __builtin_amdgcn_permlane32_swap(a1, b1, false, false); \
    u32x4 w = {r0[0], r1[0], r0[1], r1[1]}; OUT = *reinterpret_cast<bf16x8*>(&w); } while (0)
  PK4(p0, 0, pa0); PK4(p0, 8, pa1); PK4(p1, 0, pa2); PK4(p1, 8, pa3);
#undef PK4
}
__device__ __forceinline__ void qkt(f32x16& p0, f32x16& p1, const bf16* Ks, const bf16x8* qr, const bf16x8* qL, int r32, int hi) {
  p0 = f32x16{}; p1 = f32x16{};
#pragma unroll
  for (int d0 = 0; d0 < 12; ++d0) { int cb = (d0 * 16 + hi * 8) * 2;
    bf16x8 b0 = *reinterpret_cast<const bf16x8*>((const char*)Ks + KSWZ(r32, cb));
    bf16x8 b1 = *reinterpret_cast<const bf16x8*>((const char*)Ks + KSWZ(32 + r32, cb));
    const bf16x8 qf = (d0 < NQREG) ? qr[d0 < NQREG ? d0 : 0] : qL[(d0 - NQREG) * 64];
    p0 = __builtin_amdgcn_mfma_f32_32x32x16_bf16(b0, qf, p0, 0, 0, 0);
    p1 = __builtin_amdgcn_mfma_f32_32x32x16_bf16(b1, qf, p1, 0, 0, 0);
    if ((d0 & (QKT_GRP - 1)) == QKT_GRP - 1 && d0 != 11) SBAR(); }
}
__device__ __forceinline__ int v_st(int k, int c) { const int kk = (k & ~0xC) | ((k & 4) << 1) | ((k & 8) >> 1); return ((kk >> 3) * 4 + (c >> 5)) * 512 + ((kk & 7) * 32 + (c & 31)) * 2; }
__device__ __forceinline__ int v_rd_base(int lane) { return ((lane & 3) << 3) | (((lane >> 2) & 3) << 6) | (((lane >> 4) & 1) << 5) | (((lane >> 5) & 1) << 8); }
constexpr int v_rd_off(int d0, int ks, int half) { return d0 * 512 + ks * 4096 + half * 2048; }
template <int OFF> __device__ __forceinline__ s16x4 tr_read(int vb) {
  s16x4 r; asm volatile("ds_read_b64_tr_b16 %0, %1 offset:%2" : "=&v"(r) : "v"(vb), "i"(OFF) : "memory"); return r;
}
template <int D0> __device__ __forceinline__ void pv_one(f32x16& od, int vb, bf16x8 pa0, bf16x8 pa1, bf16x8 pa2, bf16x8 pa3) {
  const s16x4 l0 = tr_read<v_rd_off(D0, 0, 0)>(vb), h0 = tr_read<v_rd_off(D0, 0, 1)>(vb), l1 = tr_read<v_rd_off(D0, 1, 0)>(vb), h1 = tr_read<v_rd_off(D0, 1, 1)>(vb);
  const s16x4 l2 = tr_read<v_rd_off(D0, 2, 0)>(vb), h2 = tr_read<v_rd_off(D0, 2, 1)>(vb), l3 = tr_read<v_rd_off(D0, 3, 0)>(vb), h3 = tr_read<v_rd_off(D0, 3, 1)>(vb);
  asm volatile("s_waitcnt lgkmcnt(0)" ::: "memory"); SBAR();
#define PK(L, H) (bf16x8){L[0], L[1], L[2], L[3], H[0], H[1], H[2], H[3]}
  od = __builtin_amdgcn_mfma_f32_32x32x16_bf16(pa0, PK(l0, h0), od, 0, 0, 0);
  od = __builtin_amdgcn_mfma_f32_32x32x16_bf16(pa1, PK(l1, h1), od, 0, 0, 0);
  od = __builtin_amdgcn_mfma_f32_32x32x16_bf16(pa2, PK(l2, h2), od, 0, 0, 0);
  od = __builtin_amdgcn_mfma_f32_32x32x16_bf16(pa3, PK(l3, h3), od, 0, 0, 0);
#undef PK
}
__device__ __forceinline__ void pv_d0(f32x16* o, int vb, bf16x8 pa0, bf16x8 pa1, bf16x8 pa2, bf16x8 pa3) {
  pv_one<0>(o[0], vb, pa0, pa1, pa2, pa3); pv_one<1>(o[1], vb, pa0, pa1, pa2, pa3); pv_one<2>(o[2], vb, pa0, pa1, pa2, pa3); pv_one<3>(o[3], vb, pa0, pa1, pa2, pa3);
}
template <int SDEPTH>
__device__ __forceinline__ void attn_dense_body(const bf16* __restrict__ Qb, const bf16* __restrict__ Kc, const bf16* __restrict__ Kl, const bf16* __restrict__ Vc, const bf16* __restrict__ Vl,
                                                bf16* __restrict__ Ob, int seq, char* lds) {
  const int tid = threadIdx.x, wid = tid >> 6, lane = tid & 63, r32 = lane & 31, hi = lane >> 5;
  bf16* V_lds = (bf16*)lds; bf16* K_lds = (bf16*)(lds + 2 * SHM_V);
  float* ws = (float*)(lds + 2 * SHM_V + 2 * SHM_K) + wid * 64; float* li_l = ws; float* al_l = ws + 32;
  float m_reg = -1e30f, l_reg = 0; f32x16 o[4] = {}; bf16x8 qr[NQREG];
  bf16x8* qL = (bf16x8*)(lds + SHM_QL) + wid * (12 - NQREG) * 64 + lane;
  const bf16* Qw = Qb + (long)(wid * QBLK + r32) * LDQ + hi * 8;
#pragma unroll
  for (int d0 = 0; d0 < 12; ++d0) { const bf16x8 qv = *reinterpret_cast<const bf16x8*>(Qw + d0 * 16); if (d0 < NQREG) qr[d0 < NQREG ? d0 : 0] = qv; else qL[(d0 - NQREG) * 64] = qv; }
  const int sr = tid >> 4, sc = (tid & 15) * 8, vst0 = v_st(sr, sc), vst1 = v_st(32 + sr, sc);
  const int kr0 = tid / 24, kc0 = (tid % 24) * 8, kr1 = (tid + 512) / 24, kc1 = ((tid + 512) % 24) * 8, kr2 = (tid + 1024) / 24, kc2 = ((tid + 1024) % 24) * 8;
  const int kw0 = KSWZ(kr0, kc0 * 2), kw1 = KSWZ(kr1, kc1 * 2), kw2 = KSWZ(kr2, kc2 * 2);
  const int vb0 = (int)(uintptr_t)V_lds + v_rd_base(lane);
  struct { bf16x8 vs0, vs1, ks0, ks1, ks2; } sr_[SDEPTH];
#define KP(k0) ((k0) < 256 ? Kc + (long)(k0) * LDK : Kl + (long)((k0) - 256) * LDK)
#define VP(k0) ((k0) < 256 ? Vc + (long)(k0) * LDV : Vl + (long)((k0) - 256) * LDV)
#define SLOAD(i, k0) do { const bf16* kp_ = KP(k0); const bf16* vp_ = VP(k0); \
    sr_[i].vs0 = *reinterpret_cast<const bf16x8*>(&vp_[(long)sr * LDV + sc]); sr_[i].vs1 = *reinterpret_cast<const bf16x8*>(&vp_[(long)(32 + sr) * LDV + sc]); \
    sr_[i].ks0 = *reinterpret_cast<const bf16x8*>(&kp_[(long)kr0 * LDK + kc0]); sr_[i].ks1 = *reinterpret_cast<const bf16x8*>(&kp_[(long)kr1 * LDK + kc1]); \
    sr_[i].ks2 = *reinterpret_cast<const bf16x8*>(&kp_[(long)kr2 * LDK + kc2]); } while (0)
#define SWRITE(b, i) do { *(bf16x8*)((char*)V_lds + (b) * SHM_V + vst0) = sr_[i].vs0; *(bf16x8*)((char*)V_lds + (b) * SHM_V + vst1) = sr_[i].vs1; \
    *(bf16x8*)((char*)K_lds + (b) * SHM_K + kw0) = sr_[i].ks0; *(bf16x8*)((char*)K_lds + (b) * SHM_K + kw1) = sr_[i].ks1; *(bf16x8*)((char*)K_lds + (b) * SHM_K + kw2) = sr_[i].ks2; } while (0)
#define SWAIT() do { if constexpr (SDEPTH == 2) asm volatile("s_waitcnt vmcnt(5)" ::: "memory"); else asm volatile("s_waitcnt vmcnt(0)" ::: "memory"); } while (0)
#define RESC(a) do { if (__any((a) < 1.f)) { if (hi == 0) al_l[r32] = (a); asm volatile("s_waitcnt lgkmcnt(0)" ::: "memory"); \
    for (int d = 0; d < 4; ++d) for (int r = 0; r < 16; ++r) o[d][r] *= al_l[crow(r, hi)]; } } while (0)
  f32x16 pA0, pA1, pB0, pB1; float mnA, mnB, alA, alB; bf16x8 pa0, pa1, pa2, pa3; const int NT = seq / KVBLK;
  constexpr int SE = 0, SO = SDEPTH - 1;
  SLOAD(SE, 0); asm volatile("s_waitcnt vmcnt(0)" ::: "memory"); SWRITE(0, SE); __syncthreads();
  qkt(pA0, pA1, K_lds, qr, qL, r32, hi); partialSM(pA0, pA1, m_reg, mnA, alA);
  SLOAD(SO, KVBLK); if constexpr (SDEPTH == 2) { if (2 < NT) SLOAD(SE, 2 * KVBLK); }
  SWAIT(); SWRITE(1, SO); __syncthreads();
  for (int j = 1; j + 1 < NT; j += 2) {
    SBAR(); qkt(pB0, pB1, (bf16*)((char*)K_lds + SHM_K), qr, qL, r32, hi);
    finishSM(pA0, pA1, alA, l_reg, pa0, pa1, pa2, pa3); SBAR();
    SLOAD(SO, (j + SDEPTH) * KVBLK); SBAR();
    pv_d0(o, vb0, pa0, pa1, pa2, pa3); partialSM(pB0, pB1, m_reg, mnB, alB);
    __syncthreads(); SWAIT(); SWRITE(0, SE);
    RESC(alB); __syncthreads();
    SBAR(); qkt(pA0, pA1, K_lds, qr, qL, r32, hi);
    finishSM(pB0, pB1, alB, l_reg, pa0, pa1, pa2, pa3); SBAR();
    if (SDEPTH == 1 || j + 3 < NT) SLOAD(SE, (j + 1 + SDEPTH) * KVBLK); SBAR();
    pv_d0(o, vb0 + (int)SHM_V, pa0, pa1, pa2, pa3); partialSM(pA0, pA1, m_reg, mnA, alA);
    __syncthreads(); SWAIT(); SWRITE(1, SO);
    RESC(alA); __syncthreads();
  }
  SBAR(); qkt(pB0, pB1, (bf16*)((char*)K_lds + SHM_K), qr, qL, r32, hi);
  finishSM(pA0, pA1, alA, l_reg, pa0, pa1, pa2, pa3); SBAR();
  pv_d0(o, vb0, pa0, pa1, pa2, pa3); partialSM(pB0, pB1, m_reg, mnB, alB);
  __syncthreads(); RESC(alB);
  finishSM(pB0, pB1, alB, l_reg, pa0, pa1, pa2, pa3); SBAR();
  pv_d0(o, vb0 + (int)SHM_V, pa0, pa1, pa2, pa3);
  if (hi == 0) li_l[r32] = l_reg; asm volatile("s_waitcnt lgkmcnt(0)" ::: "memory");
  float rli[16];
#pragma unroll
  for (int r = 0; r < 16; ++r) rli[r] = __builtin_amdgcn_rcpf(li_l[crow(r, hi)]);
  bf16* Ow = Ob + (long)(wid * QBLK) * LDO;
#pragma unroll
  for (int r = 0; r < 16; ++r) { int orow = crow(r, hi);
#pragma unroll
    for (int d0 = 0; d0 < 4; ++d0) Ow[(long)orow * LDO + d0 * 32 + r32] = __float2bfloat16(o[d0][r] * rli[r]); }
  __syncthreads();
#undef KP
#undef VP
#undef SLOAD
#undef SWRITE
#undef SWAIT
#undef RESC
}
#undef KSWZ
#undef SBAR
}
constexpr int DM = 1024, NBAT = 4, SEQ = 8192, CTXL = 256, ML = NBAT * SEQ, MC = NBAT * CTXL, MT = ML + MC;
constexpr int INC = 6880, NMODC = 6144;
constexpr float EPS = 1e-6f;
constexpr int NWAVES = 8, NTHR = 512;
constexpr size_t MiB = 1u << 20;
constexpr size_t WS_CTL = 0, CTL_ZERO_BYTES = 65536; constexpr int CW_BAR = 1024;
constexpr size_t WS_ROPE = 1 * MiB + 512 * 1024;
constexpr size_t WS_MOD = 1 * MiB, WS_WIN = 2 * MiB, WS_WUQ = 16 * MiB, WS_WUKV = 18 * MiB, WS_WBG = 20 * MiB, WS_WBM = 22 * MiB, WS_WOUT = 24 * MiB, WS_WM1 = 26 * MiB, WS_WM2 = 34 * MiB;
constexpr size_t WS_BD = 42 * MiB, WS_GCU = 47 * MiB, WS_BTU = 50 * MiB, WS_HALO = 53 * MiB, WS_TCTX = 66 * MiB, WS_H = 68 * MiB;
constexpr size_t WS_CQ = 134 * MiB, WS_CKV = 159 * MiB, WS_KR = 176 * MiB, WS_KVRAW = 181 * MiB, WS_KF = 313 * MiB, WS_O = 448 * MiB;
constexpr size_t WS_QR = 134 * MiB, QKV_STRIDE = (size_t)MT * 1024  , WS_OF = 332 * MiB;
constexpr size_t WS_Z = 134 * MiB, WS_SG = 200 * MiB, WS_Y = 134 * MiB, WS_HID = 134 * MiB, WS_END = 512 * MiB;
constexpr int LDS_BYTES = 163840;

#define LAS __attribute__((address_space(3)))
typedef unsigned short bf16_t;
typedef short bf16x8 __attribute__((ext_vector_type(8)));
typedef float f32x4 __attribute__((ext_vector_type(4)));
typedef float f32x16 __attribute__((ext_vector_type(16)));
typedef unsigned u32x4 __attribute__((ext_vector_type(4)));
typedef unsigned u32x2 __attribute__((ext_vector_type(2)));
#define LDS_WAIT() asm volatile("s_waitcnt lgkmcnt(0)" ::: "memory")
__device__ __forceinline__ unsigned pk2(float lo, float hi) { return pg8::cvt_pk_s(lo, hi); }
__device__ __forceinline__ float bflo(unsigned w) { return __builtin_bit_cast(float, w << 16); }
__device__ __forceinline__ float bfhi(unsigned w) { return __builtin_bit_cast(float, w & 0xffff0000u); }
__device__ __forceinline__ float bf1(bf16_t h) { return __builtin_bit_cast(float, (unsigned)h << 16); }
__device__ __forceinline__ bf16_t f2bf(float f) { return (bf16_t)(pk2(f, 0.f) & 0xffffu); }
__device__ __forceinline__ void unpack8(u32x4 w, float* f) { f[0] = bflo(w.x); f[1] = bfhi(w.x); f[2] = bflo(w.y); f[3] = bfhi(w.y); f[4] = bflo(w.z); f[5] = bfhi(w.z); f[6] = bflo(w.w); f[7] = bfhi(w.w); }
__device__ __forceinline__ u32x4 pack8f(const float* f) { u32x4 w; w.x = pk2(f[0], f[1]); w.y = pk2(f[2], f[3]); w.z = pk2(f[4], f[5]); w.w = pk2(f[6], f[7]); return w; }
__device__ __forceinline__ float wave_sum(float v) {
#pragma unroll
    for (int o = 1; o < 64; o <<= 1) v += __shfl_xor(v, o);
    return v;
}
__device__ __forceinline__ float siluf(float x) { return x * __builtin_amdgcn_rcpf(1.f + __expf(-x)); }
__device__ __forceinline__ float rsqf(float x) { return __builtin_amdgcn_rsqf(x); }
__device__ __forceinline__ int crow(int r, int hi) { return (r & 3) + 8 * (r >> 2) + 4 * hi; }
#define MFMA32(a, b, c) __builtin_amdgcn_mfma_f32_32x32x16_bf16((a), (b), (c), 0, 0, 0)

struct Args { const float* in[24]; float* out; unsigned char* ws; int ph_lo, ph_hi; };

__device__ __forceinline__ void transpose_item(const float* W, int ldw, int col0, int K, bf16_t* WT, int row0, int nblk, LAS float* scr, int item, int lane) {
    const int kb = item / nblk, nb = item % nblk, k0 = 64 * kb, n0 = 32 * nb;
    float tw_[32];
#pragma unroll
    for (int i = 0; i < 32; ++i) { const int kk = 2 * i + (lane >> 5); tw_[i] = W[(size_t)(k0 + kk) * ldw + col0 + n0 + (lane & 31)]; }
#pragma unroll
    for (int i = 0; i < 32; ++i) { const int kk = 2 * i + (lane >> 5); scr[kk * 33 + (lane & 31)] = tw_[i]; }
    LDS_WAIT(); asm volatile("" ::: "memory");
    const int c = lane & 7;
#pragma unroll
    for (int j = 0; j < 4; ++j) { const int n = (lane >> 3) + 8 * j; const LAS float* s = scr + (8 * c) * 33 + n;
        u32x4 o; o.x = pk2(s[0 * 33], s[1 * 33]); o.y = pk2(s[2 * 33], s[3 * 33]); o.z = pk2(s[4 * 33], s[5 * 33]); o.w = pk2(s[6 * 33], s[7 * 33]);
        *(u32x4*)(WT + (size_t)(row0 + n0 + n) * K + k0 + 8 * c) = o; }
    LDS_WAIT(); asm volatile("" ::: "memory");
}
__device__ __forceinline__ void p0_prologue(const Args& a, LAS unsigned char* lds, int tid, int lane, int wave) {
    unsigned char* ws = a.ws;
    LAS float* scr = (LAS float*)(lds + wave * 16384);
    const int gw = blockIdx.x * NWAVES + wave, NGW = gridDim.x * NWAVES;
    bf16_t* WIN = (bf16_t*)(ws + WS_WIN);
    int total = 0;
#define REGION_COUNT(inidx, ldw, col0, nc, K, dst, row0) total += ((K) / 64) * ((nc) / 32);
#define REGION_RUN(inidx, ldw, col0, nc, K, dst, row0) { const int n_ = ((K) / 64) * ((nc) / 32); \
        if (rem >= 0 && rem < n_) transpose_item(a.in[inidx], ldw, col0, K, (bf16_t*)(ws + (dst)), row0, (nc) / 32, scr, rem, lane); rem -= n_; }
#define REGIONS(X) X(8, INC, 0, 4096, 1024, WS_WIN, 0) X(8, INC, 4832, 2048, 1024, WS_WIN, 4096) X(8, INC, 4128, 704, 1024, WS_WIN, 6144) X(8, INC, 4096, 32, 1024, WS_WIN, 6848) \
        X(15, 1536, 0, 1536, 384, WS_WUQ, 0) X(16, 2048, 0, 2048, 256, WS_WUKV, 0) X(19, 1024, 0, 1024, 1024, WS_WBG, 0) X(20, 1024, 0, 1024, 1024, WS_WBM, 0) \
        X(21, 1024, 0, 1024, 1024, WS_WOUT, 0) X(22, 4096, 0, 4096, 1024, WS_WM1, 0) X(23, 1024, 0, 1024, 4096, WS_WM2, 0)
    REGIONS(REGION_COUNT)
    for (int it = gw; it < total; it += NGW) { int rem = it; REGIONS(REGION_RUN) }
#undef REGIONS
#undef REGION_RUN
#undef REGION_COUNT
    for (int i = blockIdx.x * NTHR + tid; i < 32 * 1024 / 8; i += gridDim.x * NTHR) *(u32x4*)(WIN + (size_t)6880 * 1024 + (size_t)i * 8) = (u32x4){0u, 0u, 0u, 0u};
    if (blockIdx.x == gridDim.x - 1) { float* tab = (float*)(ws + WS_ROPE);
        for (int i = tid; i < 2048; i += NTHR) { const float inv = exp2f(-(float)(i & 15) * (13.287712379549449f / 16.f)); const float ang = (float)(i >> 4) * inv; tab[i] = cosf(ang); tab[2048 + i] = sinf(ang); } }
    __syncthreads();
    LAS float* sc = (LAS float*)lds;
    LAS float* red = (LAS float*)(lds + 20480);
    if ((int)blockIdx.x < NMODC / 32) {
        for (int i = tid; i < 5 * 1024; i += NTHR) { const float v = (i < 4096) ? a.in[1][i] : a.in[3][i - 4096]; sc[i] = siluf(v); }
        __syncthreads();
        const float* wm = a.in[4]; const float* bm = a.in[5]; float* mod = (float*)(ws + WS_MOD);
        for (int cb = blockIdx.x; cb < NMODC / 32; cb += gridDim.x) {
            const int cq4 = tid & 7, kg = tid >> 3, n = cb * 32 + cq4 * 4;
            f32x4 wv[16];
#pragma unroll
            for (int it = 0; it < 16; ++it) wv[it] = *(const f32x4*)(wm + (size_t)(kg + 64 * it) * NMODC + n);
            f32x4 acc[5];
#pragma unroll
            for (int r = 0; r < 5; ++r) acc[r] = (f32x4){0.f, 0.f, 0.f, 0.f};
#pragma unroll
            for (int it = 0; it < 16; ++it) {
#pragma unroll
                for (int r = 0; r < 5; ++r) acc[r] += wv[it] * sc[r * 1024 + kg + 64 * it]; }
#pragma unroll
            for (int r = 0; r < 5; ++r) *(LAS f32x4*)(red + (kg * 5 + r) * 32 + cq4 * 4) = acc[r];
            __syncthreads();
            if (tid < 160) { const int r = tid >> 5, c2 = tid & 31; float s = 0.f;
                for (int g = 0; g < 64; ++g) s += red[(g * 5 + r) * 32 + c2];
                mod[(size_t)r * NMODC + cb * 32 + c2] = s + bm[cb * 32 + c2]; }
            __syncthreads();
        }
    }
}
__device__ __forceinline__ void rms_mod_rows(const float* xl, const float* xc, int nrows, const float* nw, const float* mod, int shift_i, int scale_i, bf16_t* out, int lane, int wave) {
    const int gw = blockIdx.x * NWAVES + wave, NGW = gridDim.x * NWAVES;
    if (gw >= nrows) return;
    f32x4 wv[4];
#pragma unroll
    for (int j = 0; j < 4; ++j) wv[j] = *(const f32x4*)(nw + 4 * lane + 256 * j);
    f32x4 vn[4], vn2[4];
    { const float* xr = (gw < ML) ? xl + (size_t)gw * DM : xc + (size_t)(gw - ML) * DM;
#pragma unroll
      for (int j = 0; j < 4; ++j) vn[j] = *(const f32x4*)(xr + 4 * lane + 256 * j);
      const int m1 = (gw + NGW < nrows) ? gw + NGW : gw; const float* xr1 = (m1 < ML) ? xl + (size_t)m1 * DM : xc + (size_t)(m1 - ML) * DM;
#pragma unroll
      for (int j = 0; j < 4; ++j) vn2[j] = *(const f32x4*)(xr1 + 4 * lane + 256 * j); }
#pragma unroll 1
    for (int m = gw; m < nrows; m += NGW) {
        f32x4 v[4];
#pragma unroll
        for (int j = 0; j < 4; ++j) { v[j] = vn[j]; vn[j] = vn2[j]; }
        { const int mn = (m + 2 * NGW < nrows) ? m + 2 * NGW : m; const float* xr = (mn < ML) ? xl + (size_t)mn * DM : xc + (size_t)(mn - ML) * DM;
#pragma unroll
          for (int j = 0; j < 4; ++j) vn2[j] = *(const f32x4*)(xr + 4 * lane + 256 * j); }
        const float* mr = mod + (size_t)((m < ML) ? (m >> 13) : 4) * NMODC;
        f32x4 sh[4], scl[4];
#pragma unroll
        for (int j = 0; j < 4; ++j) { const int c = 4 * lane + 256 * j; sh[j] = *(const f32x4*)(mr + shift_i * 1024 + c); scl[j] = *(const f32x4*)(mr + scale_i * 1024 + c); }
        float s = 0.f;
#pragma unroll
        for (int j = 0; j < 4; ++j) s += (v[j].x * v[j].x + v[j].y * v[j].y) + (v[j].z * v[j].z + v[j].w * v[j].w);
        const float rs = rsqf(wave_sum(s) * (1.f / DM) + EPS);
#pragma unroll
        for (int j = 0; j < 4; ++j) { const int c = 4 * lane + 256 * j;
            const f32x4 y = (v[j] * rs * wv[j]) * (scl[j] + 1.0f) + sh[j];
            u32x2 o; o.x = pk2(y.x, y.y); o.y = pk2(y.z, y.w);
            *(u32x2*)(out + (size_t)m * DM + c) = o; }
    }
}
constexpr size_t WS_QCX = 430 * MiB, CTX_STRIDE = (size_t)1024 * 1024;
constexpr size_t WS_BEU = 440 * MiB;
constexpr size_t WS_DUMMY = 396 * MiB;
__device__ __forceinline__ void mla_prenorm(const Args& a, int lane, int wave, bool dry) {
    bf16_t* CQ = (bf16_t*)(a.ws + WS_CQ); bf16_t* CKV = (bf16_t*)(a.ws + WS_CKV); bf16_t* CQo = dry ? (bf16_t*)(a.ws + WS_DUMMY) : CQ; bf16_t* CKVo = dry ? (bf16_t*)(a.ws + WS_DUMMY + 26 * MiB) : CKV;
    const float* qn = a.in[13]; const float* kn = a.in[14];
    const int gw = blockIdx.x * NWAVES + wave, NGW = gridDim.x * NWAVES;
    const int lq = lane < 48 ? lane : 0, lk = lane < 32 ? lane : 0;
    float qw[8], kw[8];
    { const f32x4 a0 = *(const f32x4*)(qn + lq * 8), a1 = *(const f32x4*)(qn + lq * 8 + 4), b0 = *(const f32x4*)(kn + lk * 8), b1 = *(const f32x4*)(kn + lk * 8 + 4);
      qw[0] = a0.x; qw[1] = a0.y; qw[2] = a0.z; qw[3] = a0.w; qw[4] = a1.x; qw[5] = a1.y; qw[6] = a1.z; qw[7] = a1.w; kw[0] = b0.x; kw[1] = b0.y; kw[2] = b0.z; kw[3] = b0.w; kw[4] = b1.x; kw[5] = b1.y; kw[6] = b1.z; kw[7] = b1.w; }
#pragma unroll 1
    for (int m0 = gw; m0 < MT; m0 += 4 * NGW) {
        u32x4 wq[4], wk[4];
#pragma unroll
        for (int k = 0; k < 4; ++k) { const int m = (m0 + k * NGW < MT) ? m0 + k * NGW : m0; wq[k] = *(const u32x4*)(CQ + (size_t)m * 384 + lq * 8); wk[k] = *(const u32x4*)(CKV + (size_t)m * 256 + lk * 8); }
#pragma unroll
        for (int k = 0; k < 4; ++k) { const int m = m0 + k * NGW; const bool ok = m < MT;
            float f[8]; float s = 0.f; unpack8(wq[k], f);
#pragma unroll
            for (int i = 0; i < 8; ++i) s += f[i] * f[i];
            if (lane >= 48) s = 0.f;
            float rs = rsqf(wave_sum(s) * (1.f / 384.f) + EPS);
            if (ok && lane < 48) {
#pragma unroll
                for (int i = 0; i < 8; ++i) f[i] = f[i] * rs * qw[i];
                *(u32x4*)(CQo + (size_t)m * 384 + lane * 8) = pack8f(f); }
            s = 0.f; unpack8(wk[k], f);
#pragma unroll
            for (int i = 0; i < 8; ++i) s += f[i] * f[i];
            if (lane >= 32) s = 0.f;
            rs = rsqf(wave_sum(s) * (1.f / 256.f) + EPS);
            if (ok && lane < 32) {
#pragma unroll
                for (int i = 0; i < 8; ++i) f[i] = f[i] * rs * kw[i];
                *(u32x4*)(CKVo + (size_t)m * 256 + lane * 8) = pack8f(f); } }
    }
}
__device__ __forceinline__ void rope_norm8(float* f, float ss_half, const float* nrm8, int pc, bool act, bool do_rope, const float* c8, const float* s8) {
    const float rs = rsqf(ss_half * (1.f / 192.f) + EPS);
    float y[8];
#pragma unroll
    for (int i = 0; i < 8; ++i) y[i] = act ? f[i] * rs * nrm8[i] : 0.f;
    const int part = ((pc - 16) >> 1) & 1;
#pragma unroll
    for (int i = 0; i < 8; ++i) {
        const float other = __shfl_xor(y[i], 2);
        const float r = part ? (y[i] * c8[i] + other * s8[i]) : (y[i] * c8[i] - other * s8[i]);
        f[i] = (act && do_rope && pc >= 16) ? r : y[i];
    }
}
__device__ __forceinline__ void mla_finish(const Args& a, int lane, int wave, bool dry) {
    bf16_t* Q = (bf16_t*)a.out; const size_t dmask = dry ? (size_t)8191 : ~(size_t)0; bf16_t* Qo = dry ? (bf16_t*)(a.ws + WS_DUMMY) : Q; const bf16_t* KV = (const bf16_t*)(a.ws + WS_KVRAW); const bf16_t* KR = (const bf16_t*)(a.ws + WS_KR); bf16_t* KF = dry ? (bf16_t*)(a.ws + WS_DUMMY + 24 * MiB) : (bf16_t*)(a.ws + WS_KF);
    const float* qnm = a.in[17]; const float* knm = a.in[18]; const float* rtab = (const float*)(a.ws + WS_ROPE);
    const int gw = blockIdx.x * NWAVES + wave, NGW = gridDim.x * NWAVES;
    const int l32 = lane & 31, half = lane >> 5; const bool act = l32 < 24; const int pc = act ? l32 : 0, pcn = pc < 16 ? pc : 0, pcr = pc >= 16 ? pc - 16 : 0;
    float qw[8], kw[8];
    { const f32x4 a0 = *(const f32x4*)(qnm + pc * 8), a1 = *(const f32x4*)(qnm + pc * 8 + 4), b0 = *(const f32x4*)(knm + pc * 8), b1 = *(const f32x4*)(knm + pc * 8 + 4);
      qw[0] = a0.x; qw[1] = a0.y; qw[2] = a0.z; qw[3] = a0.w; qw[4] = a1.x; qw[5] = a1.y; qw[6] = a1.z; qw[7] = a1.w; kw[0] = b0.x; kw[1] = b0.y; kw[2] = b0.z; kw[3] = b0.w; kw[4] = b1.x; kw[5] = b1.y; kw[6] = b1.z; kw[7] = b1.w; }
#define MF_LOAD(mm_) do { const int m_ = (mm_); const size_t mq_ = m_ < ML ? (size_t)m_ : 0; \
        _Pragma("unroll") for (int hp = 0; hp < 4; ++hp) { const int h = 2 * hp + half; nq[hp] = *(const u32x4*)(Q + mq_ * 1536 + h * 192 + pc * 8); nkv[hp] = *(const u32x4*)(KV + (size_t)m_ * 2048 + h * 256 + pcn * 8); } \
        nkr = *(const u32x4*)(KR + (size_t)m_ * 64 + pcr * 8); \
        const int t_ = m_ & (SEQ - 1); const int pos_ = (pcr >> 2) ? (t_ & 63) : (t_ >> 6); const float* tp_ = rtab + pos_ * 16 + (pc & 1) * 8; \
        nca = *(const f32x4*)tp_; ncb = *(const f32x4*)(tp_ + 4); nsa = *(const f32x4*)(tp_ + 2048); nsb = *(const f32x4*)(tp_ + 2052); } while (0)
    u32x4 nq[4], nkv[4], nkr; f32x4 nca, ncb, nsa, nsb;
    if (gw < MT) MF_LOAD(gw);
#pragma unroll 1
    for (int m = gw; m < MT; m += NGW) {
        const bool lat = m < ML;
        u32x4 wq[4], wkv[4];
#pragma unroll
        for (int hp = 0; hp < 4; ++hp) { wq[hp] = nq[hp]; wkv[hp] = nkv[hp]; }
        const u32x4 krw = nkr; const f32x4 ca = nca, cb = ncb, sa = nsa, sb = nsb;
        MF_LOAD(m + NGW < MT ? m + NGW : m);
        const bool rp = lat && act && pc >= 16;
        const float c8[8] = {rp ? ca.x : 1.f, rp ? ca.y : 1.f, rp ? ca.z : 1.f, rp ? ca.w : 1.f, rp ? cb.x : 1.f, rp ? cb.y : 1.f, rp ? cb.z : 1.f, rp ? cb.w : 1.f};
        const float s8[8] = {rp ? sa.x : 0.f, rp ? sa.y : 0.f, rp ? sa.z : 0.f, rp ? sa.w : 0.f, rp ? sb.x : 0.f, rp ? sb.y : 0.f, rp ? sb.z : 0.f, rp ? sb.w : 0.f};
#pragma unroll
        for (int hp = 0; hp < 4; ++hp) {
            const int h = 2 * hp + half;
            if (lat) {
                float f[8]; unpack8(wq[hp], f); float s = 0.f;
#pragma unroll
                for (int i = 0; i < 8; ++i) s += f[i] * f[i];
                if (!act) s = 0.f;
#pragma unroll
                for (int o = 1; o < 32; o <<= 1) s += __shfl_xor(s, o);
                rope_norm8(f, s, qw, pc, act, true, c8, s8);
                if (act) *(u32x4*)(Qo + ((size_t)m & dmask) * 1536 + h * 192 + pc * 8) = pack8f(f);
            }
            {
                float f[8]; unpack8(pc < 16 ? wkv[hp] : krw, f); float s = 0.f;
#pragma unroll
                for (int i = 0; i < 8; ++i) s += f[i] * f[i];
                if (!act) s = 0.f;
#pragma unroll
                for (int o = 1; o < 32; o <<= 1) s += __shfl_xor(s, o);
                rope_norm8(f, s, kw, pc, act, lat, c8, s8);
                if (act) *(u32x4*)(KF + ((size_t)m & dmask) * 1536 + h * 192 + pc * 8) = pack8f(f);
            }
        }
    }
}
#undef MF_LOAD
__device__ __forceinline__ void halo_save(const Args& a, int tid) {
    const bf16_t* QKV = (const bf16_t*)(a.ws + WS_QR); bf16_t* HALO = (bf16_t*)(a.ws + WS_HALO);
    for (int idx = blockIdx.x * NTHR + tid; idx < (MT / 64) * 1536; idx += gridDim.x * NTHR) {
        const int g = idx / 1536, rem = idx % 1536, slot = rem / 384, arr = (rem % 384) >> 7, pcs = rem & 127;
        const int row = g * 64 + (slot < 2 ? slot : 60 + slot);
        *(u32x4*)(HALO + (((size_t)g * 4 + slot) * 3 + arr) * 1024 + pcs * 8) = *(const u32x4*)(QKV + (size_t)arr * QKV_STRIDE + (size_t)row * 1024 + pcs * 8);
    }
}
constexpr int PR_RAW = 0, PR_KN = 53312, PR_G = 70720, PR_GC = 87360, PR_CW = 88576;
#define PR_DECODE(u_, b_, h_, c_, nch_, rb_) do { if ((u_) < 4096) { b_ = (u_) >> 10; h_ = ((u_) >> 7) & 7; c_ = (u_) & 127; nch_ = 128; rb_ = b_ * SEQ + c_ * 64; } \
        else { const int v_ = (u_) - 4096; b_ = v_ >> 5; h_ = (v_ >> 2) & 7; c_ = v_ & 3; nch_ = 4; rb_ = ML + b_ * CTXL + c_ * 64; } } while (0)
__device__ __forceinline__ void gdn_prep(const Args& a, LAS unsigned char* lds, int tid, int lane, int wave, bool dry) {
    unsigned char* ws = a.ws;
    bf16_t* QKV = (bf16_t*)(ws + WS_QR); bf16_t* QCX = (bf16_t*)(ws + WS_QCX); const bf16_t* HALO = (const bf16_t*)(ws + WS_HALO); const float* BD = (const float*)(ws + WS_BD);
    float* GCU = (float*)(ws + WS_GCU); float* BTU = (float*)(ws + WS_BTU); float* BEU = (float*)(ws + WS_BEU); bf16_t* TL = (bf16_t*)a.out; bf16_t* TC = (bf16_t*)(ws + WS_TCTX);
    const float* convw = a.in[9]; const float* a_log = a.in[10]; const float* dt_bias = a.in[11];
    LAS bf16_t* raw = (LAS bf16_t*)(lds + PR_RAW); LAS bf16_t* kn = (LAS bf16_t*)(lds + PR_KN); LAS float* Gs = (LAS float*)(lds + PR_G);
    LAS float* gcs = (LAS float*)(lds + PR_GC); LAS float* bts = gcs + 128;
    const int r32 = lane & 31, hi = lane >> 5;
#define LBAR() do { asm volatile("s_waitcnt lgkmcnt(0)" ::: "memory"); __builtin_amdgcn_s_barrier(); asm volatile("" ::: "memory"); } while (0)
    u32x4 pr[7];
#define PR_LOADRAW(u_) do { int b_, h_, c_, nch_, rb_; PR_DECODE(u_, b_, h_, c_, nch_, rb_); const int g_ = rb_ >> 6; \
        const bf16_t* qkvb_ = (u_) < 4096 ? QKV : QCX - (size_t)ML * 1024; const size_t qst_ = (u_) < 4096 ? QKV_STRIDE : CTX_STRIDE; \
        _Pragma("unroll") for (int k_ = 0; k_ < 7; ++k_) { const int p_ = tid + 512 * k_; const int lr_ = p_ / 48, pc_ = p_ % 48, arr_ = pc_ >> 4, chp_ = pc_ & 15, i_ = lr_ - 2; \
            u32x4 w_ = {0u, 0u, 0u, 0u}; \
            if (p_ < 68 * 48) { \
                if (i_ >= 0 && i_ < 64) w_ = *(const u32x4*)(qkvb_ + (size_t)arr_ * qst_ + (size_t)(rb_ + i_) * 1024 + h_ * 128 + chp_ * 8); \
                else if (i_ < 0) { if (c_ > 0) w_ = *(const u32x4*)(HALO + (((size_t)(g_ - 1) * 4 + (2 + lr_)) * 3 + arr_) * 1024 + h_ * 128 + chp_ * 8); } \
                else { if (c_ < nch_ - 1) w_ = *(const u32x4*)(HALO + (((size_t)(g_ + 1) * 4 + (i_ - 64)) * 3 + arr_) * 1024 + h_ * 128 + chp_ * 8); } } \
            pr[k_] = w_; } } while (0)
    if ((int)blockIdx.x < 4224) PR_LOADRAW((int)blockIdx.x);
    LAS float* cws = (LAS float*)(lds + PR_CW);
    for (int i = tid; i < 5 * 3072 / 4; i += NTHR) *(LAS f32x4*)(cws + i * 4) = *(const f32x4*)(convw + i * 4);
#pragma unroll 1
    for (int u = blockIdx.x; u < 4224; u += gridDim.x) {
        int b, h, c, nch, rowbase; PR_DECODE(u, b, h, c, nch, rowbase); (void)c; (void)nch;
#pragma unroll
        for (int k = 0; k < 7; ++k) { const int p = tid + 512 * k, lr = p / 48, pc = p % 48; if (p < 68 * 48) *(LAS u32x4*)(raw + lr * 392 + pc * 8) = pr[k]; }
        LBAR();
        if (u + (int)gridDim.x < 4224) PR_LOADRAW(u + (int)gridDim.x);
        float bd_bl = 0.f, bd_dl = 0.f, bd_al = 0.f, bd_dt = 0.f;
        if (wave == 4 || wave == 5) { const int dir = wave - 4, dh = dir * 8 + h, ti = dir ? 63 - lane : lane; const size_t m = (size_t)rowbase + ti; bd_bl = BD[m * 32 + dh]; bd_dl = BD[m * 32 + 16 + dh]; bd_al = a_log[dh]; bd_dt = dt_bias[dh]; }
        { const int cgi = tid & 15, tsl = tid >> 4;
#pragma unroll
          for (int arr = 0; arr < 3; ++arr) {
            float wv[5][8];
#pragma unroll
            for (int tap = 0; tap < 5; ++tap) { const LAS float* wp = cws + tap * 3072 + arr * 1024 + h * 128 + cgi * 8; const f32x4 w0 = *(const LAS f32x4*)wp, w1 = *(const LAS f32x4*)(wp + 4);
                wv[tap][0] = w0.x; wv[tap][1] = w0.y; wv[tap][2] = w0.z; wv[tap][3] = w0.w; wv[tap][4] = w1.x; wv[tap][5] = w1.y; wv[tap][6] = w1.z; wv[tap][7] = w1.w; }
#pragma unroll
            for (int tt = 0; tt < 2; ++tt) {
                const int tok = tsl + 32 * tt;
                float acc[8];
#pragma unroll
                for (int e = 0; e < 8; ++e) acc[e] = 0.f;
#pragma unroll
                for (int tap = 0; tap < 5; ++tap) { const u32x4 w = *(const LAS u32x4*)(raw + (tok + tap) * 392 + arr * 128 + cgi * 8); float f[8]; unpack8(w, f);
#pragma unroll
                    for (int e = 0; e < 8; ++e) acc[e] += f[e] * wv[tap][e]; }
                float ss = 0.f;
#pragma unroll
                for (int e = 0; e < 8; ++e) { acc[e] = siluf(acc[e]); ss += acc[e] * acc[e]; }
                ss += __shfl_xor(ss, 1); ss += __shfl_xor(ss, 2); ss += __shfl_xor(ss, 4); ss += __shfl_xor(ss, 8);
                if (arr < 2) { const float rn = rsqf(ss + EPS);
#pragma unroll
                    for (int e = 0; e < 8; ++e) acc[e] *= rn; }
                const u32x4 o = pack8f(acc);
                if (dry) *(u32x4*)((bf16_t*)(ws + WS_DUMMY) + (size_t)arr * 8192 * 1024 + (size_t)((rowbase + tok) & 8191) * 1024 + h * 128 + cgi * 8) = o;
                else *(u32x4*)((u < 4096 ? QKV : QCX - (size_t)ML * 1024) + (size_t)arr * (u < 4096 ? QKV_STRIDE : CTX_STRIDE) + (size_t)(rowbase + tok) * 1024 + h * 128 + cgi * 8) = o;
                if (arr == 1) *(LAS u32x4*)(kn + tok * 136 + cgi * 8) = o;
            }
          } }
        LBAR();
        if (wave < 4) {
            const int it = wave >> 1, jt = wave & 1; f32x16 acc = {};
#pragma unroll
            for (int ks = 0; ks < 8; ++ks) { const bf16x8 av = *(const LAS bf16x8*)(kn + (it * 32 + r32) * 136 + ks * 16 + hi * 8), bv = *(const LAS bf16x8*)(kn + (jt * 32 + r32) * 136 + ks * 16 + hi * 8); acc = MFMA32(av, bv, acc); }
#pragma unroll
            for (int r = 0; r < 16; ++r) Gs[(it * 32 + crow(r, hi)) * 65 + jt * 32 + r32] = acc[r];
        } else if (wave < 6) {
            const int dir = wave - 4;
            const float beta = 1.f / (1.f + expf(-bd_bl));
            const float xx = bd_dl + bd_dt; const float sp = xx > 20.f ? xx : log1pf(expf(xx));
            float gcum = -expf(bd_al) * sp;
#pragma unroll
            for (int o = 1; o < 64; o <<= 1) { const float t = __shfl_up(gcum, o); if (lane >= o) gcum += t; }
            gcs[dir * 64 + lane] = gcum; bts[dir * 64 + lane] = beta;
            GCU[((size_t)u * 2 + dir) * 64 + lane] = gcum; BTU[((size_t)u * 2 + dir) * 64 + lane] = beta; BEU[((size_t)u * 2 + dir) * 64 + lane] = beta * expf(gcum);
        }
        LBAR();
        { bf16_t* Tg = (u < 4096 ? TL + (size_t)u * 8192 : TC + (size_t)(u - 4096) * 8192);
          const int e0 = tid * 16, dir = e0 >> 12, i = (e0 >> 6) & 63, j0 = e0 & 63, ti = dir ? 63 - i : i; const float bi = bts[dir * 64 + i], gi = gcs[dir * 64 + i];
          float v[16];
#pragma unroll
          for (int jj = 0; jj < 16; ++jj) { const int j = j0 + jj, tj = dir ? 63 - j : j; v[jj] = (j < i) ? bi * Gs[ti * 65 + tj] * __expf(fminf(gi - gcs[dir * 64 + j], 0.f)) : 0.f; }
          *(u32x4*)(Tg + e0) = pack8f(v); *(u32x4*)(Tg + e0 + 8) = pack8f(v + 8); }
    }
    __syncthreads();
    { LAS float* A = (LAS float*)(lds + wave * 16384);
      const int nun = (4224 - (int)blockIdx.x + (int)gridDim.x - 1) / (int)gridDim.x;
      u32x4 an[8];
      { const int it0 = wave < 2 * nun ? wave : 0; const int u0 = blockIdx.x + (it0 >> 1) * gridDim.x; const bf16_t* Tg0 = (u0 < 4096 ? TL + (size_t)u0 * 8192 : TC + (size_t)(u0 - 4096) * 8192) + (it0 & 1) * 4096;
#pragma unroll
        for (int k = 0; k < 8; ++k) an[k] = *(const u32x4*)(Tg0 + (lane + 64 * k) * 8); }
#pragma unroll 1
      for (int it = wave; it < 2 * nun; it += NWAVES) {
        const int u = blockIdx.x + (it >> 1) * gridDim.x, dir = it & 1;
        bf16_t* Tg = (u < 4096 ? TL + (size_t)u * 8192 : TC + (size_t)(u - 4096) * 8192) + dir * 4096;
#pragma unroll
        for (int k = 0; k < 8; ++k) { const int p = lane + 64 * k; float f[8]; unpack8(an[k], f);
            *(LAS f32x4*)(A + p * 8) = (f32x4){f[0], f[1], f[2], f[3]}; *(LAS f32x4*)(A + p * 8 + 4) = (f32x4){f[4], f[5], f[6], f[7]}; }
        { const int itn = (it + NWAVES < 2 * nun) ? it + NWAVES : it; const int un = blockIdx.x + (itn >> 1) * gridDim.x; const bf16_t* Tgn = (un < 4096 ? TL + (size_t)un * 8192 : TC + (size_t)(un - 4096) * 8192) + (itn & 1) * 4096;
#pragma unroll
          for (int k = 0; k < 8; ++k) an[k] = *(const u32x4*)(Tgn + (lane + 64 * k) * 8); }
        LDS_WAIT(); asm volatile("" ::: "memory");
        float t[64];
#pragma unroll
        for (int i = 0; i < 64; ++i) {
            float acc = (lane == i) ? 1.f : 0.f, ac1 = 0.f, ac2 = 0.f, ac3 = 0.f;
#pragma unroll
            for (int j4 = 0; j4 < (i + 3) / 4; ++j4) { const f32x4 a4 = *(const LAS f32x4*)(A + i * 64 + 4 * j4);
                if (4 * j4 + 0 < i) acc -= a4.x * t[4 * j4 + 0];
                if (4 * j4 + 1 < i) ac1 -= a4.y * t[4 * j4 + 1];
                if (4 * j4 + 2 < i) ac2 -= a4.z * t[4 * j4 + 2];
                if (4 * j4 + 3 < i) ac3 -= a4.w * t[4 * j4 + 3]; }
            acc = (acc + ac1) + (ac2 + ac3);
            t[i] = acc;
            Tg[i * 64 + lane] = f2bf(acc);
        }
        LDS_WAIT(); asm volatile("" ::: "memory");
      } }
    __syncthreads();
#undef LBAR
#undef PR_LOADRAW
}
constexpr int CH_QS = 0, CH_KS = 17408, CH_KT = 34816, CH_VT = 53248, CH_TP = 62464, CH_TPP = 71680, CH_W = 80896, CH_QK = 98304, CH_ST = 107520, CH_VN = 124928, CH_VND = 134144, CH_GC = 143360;
__device__ __forceinline__ void st4(LAS bf16_t* p, float a0, float a1, float a2, float a3) { u32x2 o; o.x = pk2(a0, a1); o.y = pk2(a2, a3); *(LAS u32x2*)p = o; }
__device__ __forceinline__ void gdn_chain(const Args& a, LAS unsigned char* lds, int tid, int lane, int wave) {
    if (blockIdx.x >= 128) return;
    unsigned char* ws = a.ws;
    const int w = (blockIdx.x & 7) * 16 + (blockIdx.x >> 3);
    const int b = w >> 5, h = (w >> 2) & 7, dir = (w >> 1) & 1, dvh = w & 1;
    const bf16_t* QR = (const bf16_t*)(ws + WS_QR); const bf16_t* KR = QR + QKV_STRIDE; const bf16_t* VR = QR + 2 * QKV_STRIDE;
    const float* GCU = (const float*)(ws + WS_GCU); const float* BTU = (const float*)(ws + WS_BTU); const bf16_t* TL = (const bf16_t*)a.out; const bf16_t* TC = (const bf16_t*)(ws + WS_TCTX);
    bf16_t* Od = dir ? (bf16_t*)a.out + (size_t)ML * 1024 : (bf16_t*)(ws + WS_OF);
    LAS bf16_t* qs = (LAS bf16_t*)(lds + CH_QS); LAS bf16_t* ks = (LAS bf16_t*)(lds + CH_KS); LAS bf16_t* kT = (LAS bf16_t*)(lds + CH_KT); LAS bf16_t* vT = (LAS bf16_t*)(lds + CH_VT);
    LAS bf16_t* Tp = (LAS bf16_t*)(lds + CH_TP); LAS bf16_t* Tpp = (LAS bf16_t*)(lds + CH_TPP); LAS bf16_t* wsm = (LAS bf16_t*)(lds + CH_W); LAS bf16_t* qk = (LAS bf16_t*)(lds + CH_QK);
    LAS bf16_t* ST = (LAS bf16_t*)(lds + CH_ST); LAS bf16_t* vn = (LAS bf16_t*)(lds + CH_VN); LAS bf16_t* vnd = (LAS bf16_t*)(lds + CH_VND); LAS float* gcs = (LAS float*)(lds + CH_GC);
    const int r32 = lane & 31, hi = lane >> 5;
    const float scale = 0.08838834764831845f;
    for (int i = tid; i < 64 * 136 / 8; i += NTHR) *(LAS u32x4*)(ST + i * 8) = (u32x4){0u, 0u, 0u, 0u};
    f32x16 Sacc = {};
    __syncthreads();
#define LBAR() do { asm volatile("s_waitcnt lgkmcnt(0)" ::: "memory"); __builtin_amdgcn_s_barrier(); asm volatile("" ::: "memory"); } while (0)
#define CH_UNIT(s_, u_, rb_, lat_) do { if ((s_) < 4) { const int cc_ = dir ? 3 - (s_) : (s_); u_ = 4096 + (b * 8 + h) * 4 + cc_; rb_ = ML + b * CTXL + cc_ * 64; lat_ = false; } \
        else { const int cc_ = dir ? 131 - (s_) : (s_) - 4; u_ = (b * 8 + h) * 128 + cc_; rb_ = b * SEQ + cc_ * 64; lat_ = true; } } while (0)
#define CH_LOAD(s_) do { int u_, rb_; bool lat_; CH_UNIT(s_, u_, rb_, lat_); \
        const bf16_t* Tg_ = (lat_ ? TL + (size_t)u_ * 8192 : TC + (size_t)(u_ - 4096) * 8192) + dir * 4096; \
        const float* gcu_ = GCU + ((size_t)u_ * 2 + dir) * 64; const float* btu_ = BTU + ((size_t)u_ * 2 + dir) * 64; \
        { const int ti_ = tid & 63, cg_ = tid >> 6; const size_t r0_ = (size_t)rb_ + (dir ? 63 - ti_ : ti_); \
          const bf16_t* qs_ = lat_ ? QR : (const bf16_t*)(ws + WS_QCX) - (size_t)ML * 1024; const size_t st_ = lat_ ? QKV_STRIDE : CTX_STRIDE; \
          pq0 = *(const u32x4*)(qs_ + r0_ * 1024 + h * 128 + cg_ * 8); pq1 = *(const u32x4*)(qs_ + r0_ * 1024 + h * 128 + 64 + cg_ * 8); \
          pk0 = *(const u32x4*)(qs_ + st_ + r0_ * 1024 + h * 128 + cg_ * 8); pk1 = *(const u32x4*)(qs_ + st_ + r0_ * 1024 + h * 128 + 64 + cg_ * 8); \
          pv0 = *(const u32x4*)(qs_ + 2 * st_ + r0_ * 1024 + h * 128 + dvh * 64 + cg_ * 8); } \
        { const int i_ = tid >> 3, j0_ = (tid & 7) * 8; pt0 = *(const u32x4*)(Tg_ + i_ * 64 + j0_); \
          pg0 = *(const f32x4*)(gcu_ + j0_); pg1 = *(const f32x4*)(gcu_ + j0_ + 4); pb0 = *(const f32x4*)(btu_ + j0_); pb1 = *(const f32x4*)(btu_ + j0_ + 4); } \
        pgc = gcu_[tid & 63]; pgl = gcu_[63]; } while (0)
#define CH_OSTORE(prow_) do { if (wave >= 4 && (prow_) >= 0) { const int it_ = (wave - 4) >> 1, dvt_ = (wave - 4) & 1; \
        _Pragma("unroll") for (int r = 0; r < 16; ++r) { const int i_ = it_ * 32 + crow(r, hi); const size_t row_ = (size_t)(prow_) + (dir ? 63 - i_ : i_); Od[row_ * 1024 + h * 128 + dvh * 64 + dvt_ * 32 + r32] = f2bf(oprev[r]); } } } while (0)
    u32x4 pq0, pq1, pk0, pk1, pv0, pt0; f32x4 pg0, pg1, pb0, pb1; float pgc, pgl; f32x16 oprev = {}; int prow = -1;
    CH_LOAD(0);
#pragma unroll 1
    for (int s = 0; s < 132; ++s) {
        int u, rowbase; bool lat; CH_UNIT(s, u, rowbase, lat); (void)u;
#pragma unroll
        for (int e2 = 0; e2 < 2; ++e2) { const int ti = tid & 63, cg = (tid >> 6) + 8 * e2;
            const u32x4 qv = e2 ? pq1 : pq0; *(LAS u32x4*)(qs + ti * 136 + cg * 8) = qv;
            const u32x4 kv = e2 ? pk1 : pk0; *(LAS u32x4*)(ks + ti * 136 + cg * 8) = kv;
            LAS bf16_t* kt = kT + (cg * 8) * 72 + ti;
            kt[0 * 72] = (bf16_t)(kv.x & 0xffffu); kt[1 * 72] = (bf16_t)(kv.x >> 16); kt[2 * 72] = (bf16_t)(kv.y & 0xffffu); kt[3 * 72] = (bf16_t)(kv.y >> 16);
            kt[4 * 72] = (bf16_t)(kv.z & 0xffffu); kt[5 * 72] = (bf16_t)(kv.z >> 16); kt[6 * 72] = (bf16_t)(kv.w & 0xffffu); kt[7 * 72] = (bf16_t)(kv.w >> 16); }
        { const int ti = tid & 63, cg = tid >> 6; const u32x4 vv = pv0;
            LAS bf16_t* vt = vT + (cg * 8) * 72 + ti;
            vt[0 * 72] = (bf16_t)(vv.x & 0xffffu); vt[1 * 72] = (bf16_t)(vv.x >> 16); vt[2 * 72] = (bf16_t)(vv.y & 0xffffu); vt[3 * 72] = (bf16_t)(vv.y >> 16);
            vt[4 * 72] = (bf16_t)(vv.z & 0xffffu); vt[5 * 72] = (bf16_t)(vv.z >> 16); vt[6 * 72] = (bf16_t)(vv.w & 0xffffu); vt[7 * 72] = (bf16_t)(vv.w >> 16); }
        { const int i = tid >> 3, j0 = (tid & 7) * 8; float tf[8], f1[8], f2[8]; unpack8(pt0, tf);
            const float gg[8] = {pg0.x, pg0.y, pg0.z, pg0.w, pg1.x, pg1.y, pg1.z, pg1.w}, bb[8] = {pb0.x, pb0.y, pb0.z, pb0.w, pb1.x, pb1.y, pb1.z, pb1.w};
#pragma unroll
            for (int e = 0; e < 8; ++e) { f2[e] = tf[e] * bb[e]; f1[e] = f2[e] * __expf(gg[e]); }
            *(LAS u32x4*)(Tp + i * 72 + j0) = pack8f(f1); *(LAS u32x4*)(Tpp + i * 72 + j0) = pack8f(f2); }
        if (tid < 64) gcs[tid] = pgc;
        float gc63 = pgl; asm volatile("" : "+v"(gc63));
        const float gl = __expf(gc63);
        LBAR();
        CH_OSTORE(prow);
        prow = lat ? rowbase : -1;
        if (s + 1 < 132) CH_LOAD(s + 1);
        f32x16 uacc = {};
        if (wave < 4) { const int it = wave >> 1, dvt = wave & 1;
{ bf16x8 fa_[4], fb_[4];
#pragma unroll
            for (int kk = 0; kk < 4; ++kk) { fa_[kk] = *(const LAS bf16x8*)(Tpp + (it * 32 + r32) * 72 + kk * 16 + hi * 8); fb_[kk] = *(const LAS bf16x8*)(vT + (dvt * 32 + r32) * 72 + kk * 16 + hi * 8); }
            __builtin_amdgcn_sched_barrier(0);
#pragma unroll
            for (int kk = 0; kk < 4; ++kk) uacc = MFMA32(fa_[kk], fb_[kk], uacc); } }
        { const int dkt = wave >> 1, it = wave & 1; f32x16 acc = {};
{ bf16x8 fa_[4], fb_[4];
#pragma unroll
            for (int kk = 0; kk < 4; ++kk) { fa_[kk] = *(const LAS bf16x8*)(kT + (dkt * 32 + r32) * 72 + kk * 16 + hi * 8); fb_[kk] = *(const LAS bf16x8*)(Tp + (it * 32 + r32) * 72 + kk * 16 + hi * 8); }
            __builtin_amdgcn_sched_barrier(0);
#pragma unroll
            for (int kk = 0; kk < 4; ++kk) acc = MFMA32(fa_[kk], fb_[kk], acc); }
#pragma unroll
            for (int g = 0; g < 4; ++g) st4(wsm + (it * 32 + r32) * 136 + dkt * 32 + 8 * g + 4 * hi, acc[4 * g], acc[4 * g + 1], acc[4 * g + 2], acc[4 * g + 3]); }
        if (wave >= 4) { const int it = (wave - 4) >> 1, jt = (wave - 4) & 1; f32x16 acc = {};
            if (jt <= it) {
{
#pragma unroll
                for (int kh = 0; kh < 2; ++kh) { bf16x8 fa_[4], fb_[4];
#pragma unroll
                for (int k4 = 0; k4 < 4; ++k4) { const int kk = kh * 4 + k4; fa_[k4] = *(const LAS bf16x8*)(ks + (jt * 32 + r32) * 136 + kk * 16 + hi * 8); fb_[k4] = *(const LAS bf16x8*)(qs + (it * 32 + r32) * 136 + kk * 16 + hi * 8); }
                __builtin_amdgcn_sched_barrier(0);
#pragma unroll
                for (int k4 = 0; k4 < 4; ++k4) acc = MFMA32(fa_[k4], fb_[k4], acc); } } }
            const int i = it * 32 + r32; const float gi = gcs[i];
#pragma unroll
            for (int g = 0; g < 4; ++g) { float v[4]; const int jb = jt * 32 + 8 * g + 4 * hi; const f32x4 gj = *(const LAS f32x4*)(gcs + jb);
                v[0] = (jb + 0 <= i) ? acc[4 * g + 0] * scale * __expf(fminf(gi - gj.x, 0.f)) : 0.f; v[1] = (jb + 1 <= i) ? acc[4 * g + 1] * scale * __expf(fminf(gi - gj.y, 0.f)) : 0.f;
                v[2] = (jb + 2 <= i) ? acc[4 * g + 2] * scale * __expf(fminf(gi - gj.z, 0.f)) : 0.f; v[3] = (jb + 3 <= i) ? acc[4 * g + 3] * scale * __expf(fminf(gi - gj.w, 0.f)) : 0.f;
                st4(qk + i * 72 + jb, v[0], v[1], v[2], v[3]); } }
        LBAR();
        f32x16 qS = {};
        if (wave < 4) { const int it = wave >> 1, dvt = wave & 1; f32x16 acc = {};
{
#pragma unroll
            for (int kh = 0; kh < 2; ++kh) { bf16x8 fa_[4], fb_[4];
#pragma unroll
            for (int k4 = 0; k4 < 4; ++k4) { const int kk = kh * 4 + k4; fa_[k4] = *(const LAS bf16x8*)(wsm + (it * 32 + r32) * 136 + kk * 16 + hi * 8); fb_[k4] = *(const LAS bf16x8*)(ST + (dvt * 32 + r32) * 136 + kk * 16 + hi * 8); }
            __builtin_amdgcn_sched_barrier(0);
#pragma unroll
            for (int k4 = 0; k4 < 4; ++k4) acc = MFMA32(fa_[k4], fb_[k4], acc); } }
#pragma unroll
            for (int g = 0; g < 4; ++g) { float v[4], vd[4]; const f32x4 gi4 = *(const LAS f32x4*)(gcs + it * 32 + 8 * g + 4 * hi); const float gia[4] = {gi4.x, gi4.y, gi4.z, gi4.w};
#pragma unroll
                for (int k = 0; k < 4; ++k) { v[k] = uacc[4 * g + k] - acc[4 * g + k]; vd[k] = v[k] * __expf(gc63 - gia[k]); }
                st4(vn + (dvt * 32 + r32) * 72 + it * 32 + 8 * g + 4 * hi, v[0], v[1], v[2], v[3]); st4(vnd + (dvt * 32 + r32) * 72 + it * 32 + 8 * g + 4 * hi, vd[0], vd[1], vd[2], vd[3]); }
        } else { const int it = (wave - 4) >> 1, dvt = (wave - 4) & 1;
{
#pragma unroll
            for (int kh = 0; kh < 2; ++kh) { bf16x8 fa_[4], fb_[4];
#pragma unroll
            for (int k4 = 0; k4 < 4; ++k4) { const int kk = kh * 4 + k4; fa_[k4] = *(const LAS bf16x8*)(qs + (it * 32 + r32) * 136 + kk * 16 + hi * 8); fb_[k4] = *(const LAS bf16x8*)(ST + (dvt * 32 + r32) * 136 + kk * 16 + hi * 8); }
            __builtin_amdgcn_sched_barrier(0);
#pragma unroll
            for (int k4 = 0; k4 < 4; ++k4) qS = MFMA32(fa_[k4], fb_[k4], qS); } }
#pragma unroll
            for (int g = 0; g < 4; ++g) { const f32x4 gi4 = *(const LAS f32x4*)(gcs + it * 32 + 8 * g + 4 * hi);
                qS[4 * g + 0] *= scale * __expf(gi4.x); qS[4 * g + 1] *= scale * __expf(gi4.y); qS[4 * g + 2] *= scale * __expf(gi4.z); qS[4 * g + 3] *= scale * __expf(gi4.w); } }
        LBAR();
        if (wave >= 4) { const int it = (wave - 4) >> 1, dvt = (wave - 4) & 1;
{ bf16x8 fa_[4], fb_[4];
#pragma unroll
            for (int kk = 0; kk < 4; ++kk) { fa_[kk] = *(const LAS bf16x8*)(qk + (it * 32 + r32) * 72 + kk * 16 + hi * 8); fb_[kk] = *(const LAS bf16x8*)(vn + (dvt * 32 + r32) * 72 + kk * 16 + hi * 8); }
            __builtin_amdgcn_sched_barrier(0);
#pragma unroll
            for (int kk = 0; kk < 4; ++kk) qS = MFMA32(fa_[kk], fb_[kk], qS); }
            oprev = qS; }
        { const int dkt = wave >> 1, dvt = wave & 1;
#pragma unroll
            for (int r = 0; r < 16; ++r) Sacc[r] *= gl;
{ bf16x8 fa_[4], fb_[4];
#pragma unroll
            for (int kk = 0; kk < 4; ++kk) { fa_[kk] = *(const LAS bf16x8*)(kT + (dkt * 32 + r32) * 72 + kk * 16 + hi * 8); fb_[kk] = *(const LAS bf16x8*)(vnd + (dvt * 32 + r32) * 72 + kk * 16 + hi * 8); }
            __builtin_amdgcn_sched_barrier(0);
#pragma unroll
            for (int kk = 0; kk < 4; ++kk) Sacc = MFMA32(fa_[kk], fb_[kk], Sacc); }
#pragma unroll
            for (int g = 0; g < 4; ++g) st4(ST + (dvt * 32 + r32) * 136 + dkt * 32 + 8 * g + 4 * hi, Sacc[4 * g], Sacc[4 * g + 1], Sacc[4 * g + 2], Sacc[4 * g + 3]); }
        LBAR();
    }
    CH_OSTORE(prow);
}
#undef CH_OSTORE
#undef LBAR
#undef CH_UNIT
#undef CH_LOAD
__device__ __forceinline__ void gdn_combine(const Args& a, int tid, bool dry) {
    bf16_t* OF = (bf16_t*)(a.ws + WS_OF); bf16_t* OFo = dry ? (bf16_t*)(a.ws + WS_DUMMY) : OF; const size_t dmask = dry ? (size_t)(16 * MiB - 1) : ~(size_t)0; const bf16_t* OB = (const bf16_t*)a.out + (size_t)ML * 1024; const bf16_t* Z = (const bf16_t*)(a.ws + WS_Z); const float* nw = a.in[12];
    const size_t total = (size_t)ML * 128, stride = (size_t)gridDim.x * NTHR;
    float nwv[8];
    { const int d0 = (tid & 15) * 8; const f32x4 n0 = *(const f32x4*)(nw + d0), n1 = *(const f32x4*)(nw + d0 + 4); nwv[0] = n0.x; nwv[1] = n0.y; nwv[2] = n0.z; nwv[3] = n0.w; nwv[4] = n1.x; nwv[5] = n1.y; nwv[6] = n1.z; nwv[7] = n1.w; }
#pragma unroll 1
    for (size_t idx0 = (size_t)blockIdx.x * NTHR + tid; idx0 < total; idx0 += 4 * stride) {
        u32x4 wf[4], wg[4], wz[4];
#pragma unroll
        for (int k = 0; k < 4; ++k) { const size_t idx = idx0 + k * stride, off = (idx < total ? idx : idx0) * 8; wf[k] = *(const u32x4*)(OF + off); wg[k] = *(const u32x4*)(OB + off); wz[k] = *(const u32x4*)(Z + off); }
#pragma unroll
        for (int k = 0; k < 4; ++k) { const size_t idx = idx0 + k * stride; const size_t off = idx * 8;
            float f[8], g[8], z[8]; unpack8(wf[k], f); unpack8(wg[k], g); unpack8(wz[k], z);
            float ss = 0.f;
#pragma unroll
            for (int e = 0; e < 8; ++e) { f[e] += g[e]; ss += f[e] * f[e]; }
            ss += __shfl_xor(ss, 1); ss += __shfl_xor(ss, 2); ss += __shfl_xor(ss, 4); ss += __shfl_xor(ss, 8);
            const float rs = rsqf(ss * (1.f / 128.f) + EPS);
#pragma unroll
            for (int e = 0; e < 8; ++e) f[e] = f[e] * rs * nwv[e] * siluf(z[e]);
            if (idx < total) *(u32x4*)(OFo + (off & dmask)) = pack8f(f); }
    }
}
constexpr int C2_QS = 0, C2_KT = 34816, C2_QK = 71680, C2_GC = 90112, C2_W = 90624, C2_UT = 108032, C2_KS = 112640, C2_VT = 130048, C2_TP = 134656, C2_TPP = 143872, C2_OL = 153088, C2_QL = 157696, C2_FAC = 162304, C2_END = 163328;
__device__ __forceinline__ bf16x8 rdfrag(const LAS bf16_t* p) { const u32x2 lo = *(const LAS u32x2*)p, h2 = *(const LAS u32x2*)(p + 8); const u32x4 w = {lo.x, lo.y, h2.x, h2.y}; return __builtin_bit_cast(bf16x8, w); }
#define PACKFRAG(x, s) __builtin_bit_cast(bf16x8, (u32x4){pk2((x)[8 * (s)], (x)[8 * (s) + 1]), pk2((x)[8 * (s) + 2], (x)[8 * (s) + 3]), pk2((x)[8 * (s) + 4], (x)[8 * (s) + 5]), pk2((x)[8 * (s) + 6], (x)[8 * (s) + 7])})
__device__ __forceinline__ void gdn_chain2(const Args& a, LAS unsigned char* lds, int tid, int lane, int wave) {
    unsigned char* ws = a.ws;
    const bf16_t* QR = (const bf16_t*)(ws + WS_QR); const bf16_t* KR = QR + QKV_STRIDE; const bf16_t* VR = QR + 2 * QKV_STRIDE;
    const float* GCU = (const float*)(ws + WS_GCU); const float* BTU = (const float*)(ws + WS_BTU); const float* BEU = (const float*)(ws + WS_BEU); const bf16_t* TL = (const bf16_t*)a.out; const bf16_t* TC = (const bf16_t*)(ws + WS_TCTX);
    LAS bf16_t* qs = (LAS bf16_t*)(lds + C2_QS); LAS bf16_t* kT = (LAS bf16_t*)(lds + C2_KT); LAS bf16_t* qk = (LAS bf16_t*)(lds + C2_QK); LAS float* gcs = (LAS float*)(lds + C2_GC);
    LAS bf16_t* wsm = (LAS bf16_t*)(lds + C2_W); LAS bf16_t* uT = (LAS bf16_t*)(lds + C2_UT); LAS bf16_t* ks = (LAS bf16_t*)(lds + C2_KS); LAS bf16_t* vT = (LAS bf16_t*)(lds + C2_VT);
    LAS bf16_t* Tp = (LAS bf16_t*)(lds + C2_TP); LAS bf16_t* Tpp = (LAS bf16_t*)(lds + C2_TPP); LAS bf16_t* oL = (LAS bf16_t*)(lds + C2_OL); LAS bf16_t* qL = (LAS bf16_t*)(lds + C2_QL); LAS float* fac = (LAS float*)(lds + C2_FAC);
    const int r32 = lane & 31, hi = lane >> 5, pw = wave - 1;
    const float scale = 0.08838834764831845f;
#define LBAR() do { asm volatile("s_waitcnt lgkmcnt(0)" ::: "memory"); __builtin_amdgcn_s_barrier(); asm volatile("" ::: "memory"); } while (0)
    if ((int)blockIdx.x < 256) {
    const int wi = blockIdx.x, w = (wi & 7) * 32 + (wi >> 3);
    const int b = w >> 6, h = (w >> 3) & 7, dir = (w >> 2) & 1, dvq = w & 3;
    bf16_t* Od = dir ? (bf16_t*)a.out + (size_t)ML * 1024 : (bf16_t*)(ws + WS_OF);
#define C2_UNIT(s_, u_, rb_, lat_) do { if ((s_) < 4) { const int cc_ = dir ? 3 - (s_) : (s_); u_ = 4096 + (b * 8 + h) * 4 + cc_; rb_ = ML + b * CTXL + cc_ * 64; lat_ = false; } \
        else { const int cc_ = dir ? 131 - (s_) : (s_) - 4; u_ = (b * 8 + h) * 128 + cc_; rb_ = b * SEQ + cc_ * 64; lat_ = true; } } while (0)
    u32x4 xq0, xq1, xq2, xk0, xk1, xk2, xv0, xt0, xt1; f32x4 xg0, xg1, xb0, xb1; float pgc;
#define C2_LOAD(s_) do { int u_, rb_; bool lat_; C2_UNIT(s_, u_, rb_, lat_); \
        const bf16_t* Tg_ = (lat_ ? TL + (size_t)u_ * 8192 : TC + (size_t)(u_ - 4096) * 8192) + dir * 4096; \
        const float* gcu_ = GCU + ((size_t)u_ * 2 + dir) * 64; const float* btu_ = BTU + ((size_t)u_ * 2 + dir) * 64; const float* beu_ = BEU + ((size_t)u_ * 2 + dir) * 64; \
        const bf16_t* QRs_ = lat_ ? QR : (const bf16_t*)(ws + WS_QCX) - (size_t)ML * 1024; const size_t st_ = lat_ ? QKV_STRIDE : CTX_STRIDE; \
        { const int ptid_ = tid - 64; const bf16_t* qb_ = QRs_ + (size_t)rb_ * 1024 + h * 128; \
          _Pragma("unroll") for (int m_ = 0; m_ < 3; ++m_) { const int p_ = ptid_ + 448 * m_, t_ = (p_ >> 4) & 63, c_ = p_ & 15; const u32x4 v_ = *(const u32x4*)(qb_ + (size_t)(dir ? 63 - t_ : t_) * 1024 + c_ * 8); if (m_ == 0) xq0 = v_; else if (m_ == 1) xq1 = v_; else xq2 = v_; } \
          xt0 = *(const u32x4*)(Tg_ + ptid_ * 8); xt1 = *(const u32x4*)(Tg_ + (448 + lane) * 8); \
          xg0 = *(const f32x4*)(beu_ + (lane & 7) * 8); xg1 = *(const f32x4*)(beu_ + (lane & 7) * 8 + 4); xb0 = *(const f32x4*)(btu_ + (lane & 7) * 8); xb1 = *(const f32x4*)(btu_ + (lane & 7) * 8 + 4); } \
        { const bf16_t* kb_ = QRs_ + st_ + (size_t)rb_ * 1024 + h * 128; const bf16_t* vb_ = QRs_ + 2 * st_ + (size_t)rb_ * 1024 + h * 128 + dvq * 32; \
          _Pragma("unroll") for (int m_ = 0; m_ < 3; ++m_) { const int blk_ = (pw + 7 * m_) & 15, t_ = (blk_ & 3) * 16 + (lane & 15), c_ = (blk_ >> 2) * 4 + (lane >> 4); \
              const u32x4 v_ = *(const u32x4*)(kb_ + (size_t)(dir ? 63 - t_ : t_) * 1024 + c_ * 8); if (m_ == 0) xk0 = v_; else if (m_ == 1) xk1 = v_; else xk2 = v_; } \
          { const int t_ = (pw & 3) * 16 + (lane & 15), c_ = lane >> 4; xv0 = *(const u32x4*)(vb_ + (size_t)(dir ? 63 - t_ : t_) * 1024 + c_ * 8); } } \
        pgc = gcu_[lane]; } while (0)
#ifdef EXP_DUPK
#define C2_DUPK(d, v) do { asm volatile("" ::: "memory"); C2_TR8(d, v); asm volatile("" ::: "memory"); } while (0)
#else
#define C2_DUPK(d, v) do {} while (0)
#endif
#define C2_TR8(dst_, v_) do { LAS bf16_t* d_ = (dst_); d_[0 * 72] = (bf16_t)((v_).x & 0xffffu); d_[1 * 72] = (bf16_t)((v_).x >> 16); d_[2 * 72] = (bf16_t)((v_).y & 0xffffu); d_[3 * 72] = (bf16_t)((v_).y >> 16); \
        d_[4 * 72] = (bf16_t)((v_).z & 0xffffu); d_[5 * 72] = (bf16_t)((v_).z >> 16); d_[6 * 72] = (bf16_t)((v_).w & 0xffffu); d_[7 * 72] = (bf16_t)((v_).w >> 16); } while (0)
#define C2_TPIECE(p_, tv_) do { const int i_ = (p_) >> 3, c8_ = (p_) & 7; float tf_[8], f1_[8], f2_[8]; unpack8(tv_, tf_); \
        const float gg_[8] = {xg0.x, xg0.y, xg0.z, xg0.w, xg1.x, xg1.y, xg1.z, xg1.w}, bb_[8] = {xb0.x, xb0.y, xb0.z, xb0.w, xb1.x, xb1.y, xb1.z, xb1.w}; \
        _Pragma("unroll") for (int e_ = 0; e_ < 8; ++e_) { f2_[e_] = tf_[e_] * bb_[e_]; f1_[e_] = tf_[e_] * gg_[e_]; } \
        *(LAS u32x4*)(Tp + i_ * 72 + c8_ * 8) = pack8f(f1_); *(LAS u32x4*)(Tpp + i_ * 72 + c8_ * 8) = pack8f(f2_); } while (0)
#define C2_STAGE_A(nb_) do { LAS bf16_t* qsn_ = qs + (nb_) * 8704; LAS bf16_t* kTn_ = kT + (nb_) * 9216; const int ptid_ = tid - 64; \
        { const int p0_ = ptid_, p1_ = ptid_ + 448, p2_ = ptid_ + 896; \
          *(LAS u32x4*)(qsn_ + (p0_ >> 4) * 136 + (p0_ & 15) * 8) = xq0; *(LAS u32x4*)(qsn_ + (p1_ >> 4) * 136 + (p1_ & 15) * 8) = xq1; if (p2_ < 1024) *(LAS u32x4*)(qsn_ + (p2_ >> 4) * 136 + (p2_ & 15) * 8) = xq2; } \
        { const int b0_ = pw, b1_ = pw + 7, b2_ = pw + 14, tl_ = lane & 15, cl_ = lane >> 4; \
          { const int t_ = (b0_ & 3) * 16 + tl_, c_ = (b0_ >> 2) * 4 + cl_; *(LAS u32x4*)(ks + t_ * 136 + c_ * 8) = xk0; C2_TR8(kTn_ + (c_ * 8) * 72 + t_, xk0); C2_DUPK(kTn_ + (c_ * 8) * 72 + t_, xk0); } \
          { const int t_ = (b1_ & 3) * 16 + tl_, c_ = (b1_ >> 2) * 4 + cl_; *(LAS u32x4*)(ks + t_ * 136 + c_ * 8) = xk1; C2_TR8(kTn_ + (c_ * 8) * 72 + t_, xk1); C2_DUPK(kTn_ + (c_ * 8) * 72 + t_, xk1); } \
          if (b2_ < 16) { const int t_ = (b2_ & 3) * 16 + tl_, c_ = (b2_ >> 2) * 4 + cl_; *(LAS u32x4*)(ks + t_ * 136 + c_ * 8) = xk2; C2_TR8(kTn_ + (c_ * 8) * 72 + t_, xk2); } \
          if (pw < 4) { const int t_ = pw * 16 + tl_; C2_TR8(vT + (cl_ * 8) * 72 + t_, xv0); } } \
        C2_TPIECE(ptid_, xt0); if (pw == 6) C2_TPIECE(448 + lane, xt1); \
        if (pw == 1) { gcs[(nb_) * 64 + lane] = pgc; const float g63_ = __shfl(pgc, 63); fac[(nb_) * 128 + lane] = scale * __expf(pgc); fac[(nb_) * 128 + 64 + lane] = __expf(g63_ - pgc); } } while (0)
#define C2_WJOB(jw_) do { const int dkt_ = (jw_) >> 1, it_ = (jw_) & 1; f32x16 acc_ = {}; bf16x8 fa_[4], fb_[4]; \
        _Pragma("unroll") for (int kk = 0; kk < 4; ++kk) { fa_[kk] = *(const LAS bf16x8*)(kTn + (dkt_ * 32 + r32) * 72 + kk * 16 + hi * 8); fb_[kk] = *(const LAS bf16x8*)(Tp + (it_ * 32 + r32) * 72 + kk * 16 + hi * 8); } \
        _Pragma("unroll") for (int kk = 0; kk < 4; ++kk) acc_ = MFMA32(fa_[kk], fb_[kk], acc_); \
        _Pragma("unroll") for (int g = 0; g < 4; ++g) st4(wsm + (it_ * 32 + r32) * 136 + dkt_ * 32 + 8 * g + 4 * hi, acc_[4 * g], acc_[4 * g + 1], acc_[4 * g + 2], acc_[4 * g + 3]); } while (0)
#define C2_UJOB(it_) do { f32x16 acc_ = {}; bf16x8 fa_[4], fb_[4]; \
        _Pragma("unroll") for (int kk = 0; kk < 4; ++kk) { fa_[kk] = *(const LAS bf16x8*)(Tpp + ((it_) * 32 + r32) * 72 + kk * 16 + hi * 8); fb_[kk] = *(const LAS bf16x8*)(vT + r32 * 72 + kk * 16 + hi * 8); } \
        _Pragma("unroll") for (int kk = 0; kk < 4; ++kk) acc_ = MFMA32(fa_[kk], fb_[kk], acc_); \
        _Pragma("unroll") for (int g = 0; g < 4; ++g) st4(uT + r32 * 72 + (it_) * 32 + 8 * g + 4 * hi, acc_[4 * g], acc_[4 * g + 1], acc_[4 * g + 2], acc_[4 * g + 3]); } while (0)
#define C2_QKJOB(it_, jt_) do { f32x16 acc_ = {}; \
        _Pragma("unroll") for (int kh = 0; kh < 2; ++kh) { bf16x8 fa_[4], fb_[4]; \
            _Pragma("unroll") for (int k4 = 0; k4 < 4; ++k4) { const int kk = kh * 4 + k4; fa_[k4] = *(const LAS bf16x8*)(ks + ((jt_) * 32 + r32) * 136 + kk * 16 + hi * 8); fb_[k4] = *(const LAS bf16x8*)(qsn + ((it_) * 32 + r32) * 136 + kk * 16 + hi * 8); } \
            _Pragma("unroll") for (int k4 = 0; k4 < 4; ++k4) acc_ = MFMA32(fa_[k4], fb_[k4], acc_); } \
        const int i_ = (it_) * 32 + r32; const float gi_ = gcn[i_]; \
        _Pragma("unroll") for (int g = 0; g < 4; ++g) { const int jb_ = (jt_) * 32 + 8 * g + 4 * hi; const f32x4 gj_ = *(const LAS f32x4*)(gcn + jb_); \
            const float v0_ = (jb_ + 0 <= i_) ? acc_[4 * g + 0] * scale * __expf(fminf(gi_ - gj_.x, 0.f)) : 0.f, v1_ = (jb_ + 1 <= i_) ? acc_[4 * g + 1] * scale * __expf(fminf(gi_ - gj_.y, 0.f)) : 0.f; \
            const float v2_ = (jb_ + 2 <= i_) ? acc_[4 * g + 2] * scale * __expf(fminf(gi_ - gj_.z, 0.f)) : 0.f, v3_ = (jb_ + 3 <= i_) ? acc_[4 * g + 3] * scale * __expf(fminf(gi_ - gj_.w, 0.f)) : 0.f; \
            st4(qkn + i_ * 72 + jb_, v0_, v1_, v2_, v3_); } } while (0)
#define C2_STAGE_B(nb_) do { const LAS bf16_t* qsn = qs + (nb_) * 8704; const LAS bf16_t* kTn = kT + (nb_) * 9216; LAS bf16_t* qkn = qk + (nb_) * 4608; const LAS float* gcn = gcs + (nb_) * 64; \
        if (pw == 0) { C2_QKJOB(0, 0); C2_UJOB(0); } else if (pw == 1) C2_QKJOB(1, 0); else if (pw == 2) C2_QKJOB(1, 1); \
        else if (pw == 3) { C2_UJOB(1); C2_WJOB(0); C2_WJOB(1); } else if (pw == 4) { C2_WJOB(2); C2_WJOB(3); } \
        else if (pw == 5) { C2_WJOB(4); C2_WJOB(5); } else { C2_WJOB(6); C2_WJOB(7); } } while (0)
#define C2_OSTORE(sprev_) do { int u_, rb_; bool lat_; C2_UNIT(sprev_, u_, rb_, lat_); (void)u_; \
        if (lat_ && pw < 4) { unsigned o_[8]; _Pragma("unroll") for (int e_ = 0; e_ < 8; ++e_) o_[e_] = oL[((sprev_) & 1) * 2304 + (pw * 8 + e_) * 72 + lane]; \
            u32x4 ow_; ow_.x = o_[0] | (o_[1] << 16); ow_.y = o_[2] | (o_[3] << 16); ow_.z = o_[4] | (o_[5] << 16); ow_.w = o_[6] | (o_[7] << 16); \
            *(u32x4*)(Od + ((size_t)rb_ + (dir ? 63 - lane : lane)) * 1024 + h * 128 + dvq * 32 + pw * 8) = ow_; } } while (0)
    if (wave == 0) {
    f32x16 S0 = {}, S1 = {}, S2 = {}, S3 = {};
    LBAR();
    LBAR();
#pragma unroll 1
    for (int s = 0; s < 132; ++s) {
        const int p = s & 1;
        int l136 = r32 * 136 + 4 * hi, l72 = r32 * 72 + 4 * hi, h4 = 4 * hi; asm volatile("" : "+v"(l136), "+v"(l72), "+v"(h4));
        const LAS bf16_t* qsp = qs + p * 8704 + l136; const LAS bf16_t* kTp = kT + p * 9216 + l72; const LAS bf16_t* qkp = qk + p * 4608 + l72; const LAS float* gcp = gcs + p * 64 + h4; const LAS float* gcp0 = gcs + p * 64; const LAS float* f1p = fac + p * 128 + h4; const LAS float* f2p = f1p + 64;
        const LAS bf16_t* wsl = wsm + l136; const LAS bf16_t* uTl = uT + l72; LAS bf16_t* oLl = oL + p * 2304 + l72;
        f32x16 vn0, vn1; bf16x8 vc00, vc01, vc10, vc11;
#ifdef EXP_SLEEP_C1
        __builtin_amdgcn_s_sleep(16);
#endif
        {
            const bf16x8 sb00 = PACKFRAG(S0, 0), sb01 = PACKFRAG(S0, 1), sb10 = PACKFRAG(S1, 0), sb11 = PACKFRAG(S1, 1), sb20 = PACKFRAG(S2, 0), sb21 = PACKFRAG(S2, 1), sb30 = PACKFRAG(S3, 0), sb31 = PACKFRAG(S3, 1);
#define C2_SDOT(acc_, base_) do { const LAS bf16_t* b_ = (base_); \
            acc_ = MFMA32(rdfrag(b_ + 0), sb00, acc_); acc_ = MFMA32(rdfrag(b_ + 16), sb01, acc_); acc_ = MFMA32(rdfrag(b_ + 32), sb10, acc_); acc_ = MFMA32(rdfrag(b_ + 48), sb11, acc_); \
            acc_ = MFMA32(rdfrag(b_ + 64), sb20, acc_); acc_ = MFMA32(rdfrag(b_ + 80), sb21, acc_); acc_ = MFMA32(rdfrag(b_ + 96), sb30, acc_); acc_ = MFMA32(rdfrag(b_ + 112), sb31, acc_); } while (0)
            { f32x16 acc = {}; C2_SDOT(acc, wsl);
#pragma unroll
              for (int g = 0; g < 4; ++g) { const u32x2 uu = *(const LAS u32x2*)(uTl + 0 * 32 + 8 * g);
                  vn0[4 * g + 0] = bflo(uu.x) - acc[4 * g + 0]; vn0[4 * g + 1] = bfhi(uu.x) - acc[4 * g + 1]; vn0[4 * g + 2] = bflo(uu.y) - acc[4 * g + 2]; vn0[4 * g + 3] = bfhi(uu.y) - acc[4 * g + 3]; } }
            { f32x16 acc = {}; C2_SDOT(acc, wsl + 32 * 136);
#pragma unroll
              for (int g = 0; g < 4; ++g) { const u32x2 uu = *(const LAS u32x2*)(uTl + 1 * 32 + 8 * g);
                  vn1[4 * g + 0] = bflo(uu.x) - acc[4 * g + 0]; vn1[4 * g + 1] = bfhi(uu.x) - acc[4 * g + 1]; vn1[4 * g + 2] = bflo(uu.y) - acc[4 * g + 2]; vn1[4 * g + 3] = bfhi(uu.y) - acc[4 * g + 3]; } }
            f32x16 qa = {}, qb = {};
            C2_SDOT(qa, qsp); C2_SDOT(qb, qsp + 32 * 136);
#pragma unroll
            for (int g = 0; g < 4; ++g) { const f32x4 ga = *(const LAS f32x4*)(f1p + 0 * 32 + 8 * g), gb = *(const LAS f32x4*)(f1p + 1 * 32 + 8 * g);
                qa[4 * g + 0] *= ga.x; qa[4 * g + 1] *= ga.y; qa[4 * g + 2] *= ga.z; qa[4 * g + 3] *= ga.w;
                qb[4 * g + 0] *= gb.x; qb[4 * g + 1] *= gb.y; qb[4 * g + 2] *= gb.z; qb[4 * g + 3] *= gb.w; }
            __builtin_amdgcn_sched_barrier(0);
            { const bf16x8 vb00 = PACKFRAG(vn0, 0), vb01 = PACKFRAG(vn0, 1), vb10 = PACKFRAG(vn1, 0), vb11 = PACKFRAG(vn1, 1);
              qa = MFMA32(rdfrag(qkp + 0), vb00, qa); qa = MFMA32(rdfrag(qkp + 16), vb01, qa);
              const LAS bf16_t* b_ = qkp + 32 * 72;
              qb = MFMA32(rdfrag(b_ + 0), vb00, qb); qb = MFMA32(rdfrag(b_ + 16), vb01, qb); qb = MFMA32(rdfrag(b_ + 32), vb10, qb); qb = MFMA32(rdfrag(b_ + 48), vb11, qb);
#pragma unroll
              for (int g = 0; g < 4; ++g) { st4(oLl + 0 * 32 + 8 * g, qa[4 * g], qa[4 * g + 1], qa[4 * g + 2], qa[4 * g + 3]); st4(oLl + 1 * 32 + 8 * g, qb[4 * g], qb[4 * g + 1], qb[4 * g + 2], qb[4 * g + 3]); } }
            __builtin_amdgcn_sched_barrier(0);
#pragma unroll
            for (int g = 0; g < 4; ++g) { const f32x4 ga = *(const LAS f32x4*)(f2p + 0 * 32 + 8 * g), gb = *(const LAS f32x4*)(f2p + 1 * 32 + 8 * g);
                vn0[4 * g + 0] *= ga.x; vn0[4 * g + 1] *= ga.y; vn0[4 * g + 2] *= ga.z; vn0[4 * g + 3] *= ga.w;
                vn1[4 * g + 0] *= gb.x; vn1[4 * g + 1] *= gb.y; vn1[4 * g + 2] *= gb.z; vn1[4 * g + 3] *= gb.w; }
            vc00 = PACKFRAG(vn0, 0); vc01 = PACKFRAG(vn0, 1); vc10 = PACKFRAG(vn1, 0); vc11 = PACKFRAG(vn1, 1);
#undef C2_SDOT
        }
        LBAR();
        {
#ifdef EXP_SLEEP_C2
            __builtin_amdgcn_s_sleep(16);
#endif
            const float gl = __expf(gcp0[63]);
            { bf16x8 ka[4][4];
#pragma unroll
              for (int t = 0; t < 4; ++t)
#pragma unroll
                for (int q = 0; q < 4; ++q) ka[t][q] = rdfrag(kTp + t * 32 * 72 + q * 16);
#pragma unroll
              for (int r = 0; r < 16; ++r) { S0[r] *= gl; S1[r] *= gl; S2[r] *= gl; S3[r] *= gl; }
              S0 = MFMA32(ka[0][0], vc00, S0); S1 = MFMA32(ka[1][0], vc00, S1); S2 = MFMA32(ka[2][0], vc00, S2); S3 = MFMA32(ka[3][0], vc00, S3);
              S0 = MFMA32(ka[0][1], vc01, S0); S1 = MFMA32(ka[1][1], vc01, S1); S2 = MFMA32(ka[2][1], vc01, S2); S3 = MFMA32(ka[3][1], vc01, S3);
              S0 = MFMA32(ka[0][2], vc10, S0); S1 = MFMA32(ka[1][2], vc10, S1); S2 = MFMA32(ka[2][2], vc10, S2); S3 = MFMA32(ka[3][2], vc10, S3);
              S0 = MFMA32(ka[0][3], vc11, S0); S1 = MFMA32(ka[1][3], vc11, S1); S2 = MFMA32(ka[2][3], vc11, S2); S3 = MFMA32(ka[3][3], vc11, S3); }
        }
        LBAR();
    }
    LBAR();
    } else {
    C2_LOAD(0); C2_STAGE_A(0);
    LBAR();
    C2_LOAD(1); C2_STAGE_B(0);
    LBAR();
#pragma unroll 1
    for (int s = 0; s < 132; ++s) {
        const int np = (s & 1) ^ 1;
#ifdef EXP_SLEEP_P1
        __builtin_amdgcn_s_sleep(16);
#endif
        if (s + 1 < 132) C2_STAGE_A(np);
        if (s > 0) C2_OSTORE(s - 1);
        if (s + 2 < 132) C2_LOAD(s + 2);
        LBAR();
        if (s + 1 < 132) C2_STAGE_B(np);
        LBAR();
    }
    C2_OSTORE(131);
    LBAR();
    }
    }
#undef LBAR
#undef C2_UNIT
#undef C2_LOAD
#undef C2_TR8
#undef C2_TPIECE
#undef C2_STAGE_A
#undef C2_WJOB
#undef C2_UJOB
#undef C2_QKJOB
#undef C2_STAGE_B
#undef C2_OSTORE
}
#define GAS __attribute__((address_space(1)))
#define XB_TMO      128
#define XB_XCNT(j)  (256  + 64 * (j))
#define XB_XSUB(j)  (1280 + 64 * (j))
#define XB_XGEN(j)  (2304 + 64 * (j))
#define XB_TOP      3328
#define XB_TOPGEN   3392
#define XCD_BAR_WORDS 3456
#define XB_SPIN_CAP (1u << 18)
#ifndef XB_SLEEP
#define XB_SLEEP 2
#endif

__device__ __forceinline__ unsigned xb_ld(unsigned* p)              { return __hip_atomic_load(p, __ATOMIC_RELAXED, __HIP_MEMORY_SCOPE_AGENT); }
__device__ __forceinline__ unsigned xb_add(unsigned* p, unsigned v) { return __hip_atomic_fetch_add(p, v, __ATOMIC_RELAXED, __HIP_MEMORY_SCOPE_AGENT); }
__device__ __forceinline__ unsigned xb_xcc_id() { return (unsigned)__builtin_amdgcn_s_getreg((3 << 11) | 20) & 0xFu; }
#define XB_SPIN(cond, bar) do { unsigned _sp = 0; while (cond) { __builtin_amdgcn_s_sleep(XB_SLEEP); \
    if ((++_sp & 255u) == 0u) { if (xb_ld(&(bar)[XB_TMO])) break; if (_sp > XB_SPIN_CAP) { atomicAdd(&(bar)[XB_TMO], 1u); break; } } } } while (0)

struct XcdBarrier {
    unsigned* bar; unsigned x;
    volatile LAS unsigned* st;
};

__device__ __forceinline__ XcdBarrier xcd_barrier_post(unsigned* bar, volatile LAS unsigned* st) {
    XcdBarrier b; b.bar = bar; b.x = xb_xcc_id(); b.st = st;
    if (threadIdx.x == 0) (void)xb_add(&bar[XB_XCNT(b.x)], 1u);
    return b;
}
__device__ __forceinline__ void xcd_barrier_complete(unsigned* bar, unsigned x, unsigned& nloc, unsigned& nx) {
    const unsigned G = gridDim.x * gridDim.y * gridDim.z;
    unsigned sum, cnt, mine, sp = 0u;
    for (;;) {
        sum = 0u; cnt = 0u; mine = 0u;
#pragma unroll
        for (unsigned j = 0; j < 16; ++j) { const unsigned c = xb_ld(&bar[XB_XCNT(j)]); sum += c; cnt += (c > 0u) ? 1u : 0u; mine = (j == x) ? c : mine; }
        if (sum == G) break;
        __builtin_amdgcn_s_sleep(XB_SLEEP);
        if ((++sp & 255u) == 0u) { if (xb_ld(&bar[XB_TMO])) break; if (sp > XB_SPIN_CAP) { atomicAdd(&bar[XB_TMO], 1u); break; } }
    }
    nloc = mine > 0u ? mine : 1u; nx = cnt > 0u ? cnt : 1u;
}

__device__ __forceinline__ void xcd_barrier(const XcdBarrier& b) {
    asm volatile("s_waitcnt vmcnt(0)" ::: "memory");
    __syncthreads();
    if (threadIdx.x == 0) {
        unsigned* bar = b.bar;
        __builtin_amdgcn_s_waitcnt(0);
        unsigned nloc = b.st[0], nx = b.st[1];
        if (nloc == 0u) { xcd_barrier_complete(bar, b.x, nloc, nx); b.st[0] = nloc; b.st[1] = nx; }
        const unsigned old = xb_add(&bar[XB_XSUB(b.x)], 1u);
        const unsigned gen = old / nloc;
        if (old + 1u == (gen + 1u) * nloc) {
            __builtin_amdgcn_fence(__ATOMIC_RELEASE, "agent");
            asm volatile("s_waitcnt vmcnt(0)" ::: "memory");
            const unsigned og = xb_add(&bar[XB_TOP], 1u);
            const unsigned tg = og / nx;
            if (og + 1u == (tg + 1u) * nx) xb_add(&bar[XB_TOPGEN], 1u);
            else XB_SPIN(xb_ld(&bar[XB_TOPGEN]) == tg, bar);
            __builtin_amdgcn_fence(__ATOMIC_ACQUIRE, "agent");
            xb_add(&bar[XB_XGEN(b.x)], 1u);
            asm volatile("s_waitcnt vmcnt(0)" ::: "memory");
        } else {
            XB_SPIN(xb_ld(&bar[XB_XGEN(b.x)]) == gen, bar);
            __builtin_amdgcn_fence(__ATOMIC_ACQUIRE, "agent");
            asm volatile("s_waitcnt vmcnt(0)" ::: "memory");
        }
    }
    __syncthreads();
}

constexpr int N_PHASES = 19;
#ifndef CHAIN_FN
#define CHAIN_FN gdn_chain2
#endif
#ifndef REP_ATT
#define REP_ATT 1
#endif
#ifndef REP_CHAIN
#define REP_CHAIN 1
#endif
#ifndef REP_SMALL
#define REP_SMALL 0
#endif
#ifndef REP_PREP
#define REP_PREP 0
#endif
#ifndef REP_GEMM
#define REP_GEMM 1
#endif
#ifndef MK_PER_PHASE
#define MK_PER_PHASE 0
#endif
struct PassASched { int G, c;
    __device__ __forceinline__ bool next(int i, pg8::Unit& u) const {
        if (G == 256) {
            const int x = c & 7, q = (c >> 3) + 32 * i, np = (x < 4) ? 17 : 16;
            if (q < 3 * np) { u.pm = x + 8 * (q / 3); u.pn = 24 + q % 3; return true; }
            const int r = q - 3 * np; if (r < 6) { const int e = x * 6 + r; u.pm = 128 + (e & 3); u.pn = e >> 2; return true; }
            return false; }
        const int L = i * G + c;
        if (L < 396) { u.pm = L % 132; u.pn = 24 + L / 132; return true; }
        if (L < 444) { const int L2 = L - 396; u.pm = 128 + (L2 & 3); u.pn = L2 >> 2; return true; }
        return false; }
    __device__ __forceinline__ void a_ready(const pg8::Unit&) const {}
    __device__ __forceinline__ void done(const pg8::Unit&) const {} };
template <class Op> __device__ __forceinline__ void run_gemm(LAS unsigned char* lds, const bf16_t* A, const bf16_t* Bt, int M, int N, int K, const Op& op) {
    pg8::Gemm g{A, Bt, M, N, K}; pg8::StaticOrder S; S.init(M, N, (int)gridDim.x, (int)blockIdx.x);
    pg8::EpiOp<Op> E{op};
    pg8::gemm_phase<pg8::EpiOp<Op>, pg8::StaticOrder, true, true>(lds, g, S, E);
}
__global__ void __launch_bounds__(NTHR, 2) fwd_kernel(Args a) {
    extern __shared__ __attribute__((aligned(16))) unsigned char lds_[];
    LAS unsigned char* lds = (LAS unsigned char*)lds_;
    cg::grid_group grid = cg::this_grid();
    const int tid = threadIdx.x, lane = tid & 63, wave = __builtin_amdgcn_readfirstlane(tid >> 6);
    const int lo = a.ph_lo, hi = a.ph_hi;
    volatile LAS unsigned* bst = (volatile LAS unsigned*)(lds + LDS_BYTES - 64);
    if (tid < 2) bst[tid] = 0u;
    __syncthreads();
    XcdBarrier xbar = xcd_barrier_post((unsigned*)(a.ws + WS_CTL) + CW_BAR, bst);
    unsigned char* ws = a.ws;
    const float* x = a.in[0]; const float* ctx = a.in[2]; float* out = a.out;
    float* MOD = (float*)(ws + WS_MOD);
    bf16_t* WIN = (bf16_t*)(ws + WS_WIN); bf16_t* H = (bf16_t*)(ws + WS_H);
#ifndef PH_MASK
#define PH_MASK 0x7ffff
#endif
#define IN(k) ((((PH_MASK) >> (k)) & 1) && lo <= (k) && (k) < hi)
#define SEAM(k) do { if (IN(k) && IN((k) + 1)) xcd_barrier(xbar); } while (0)
#ifdef REP_SYNC
    for (int i_ = 0; i_ < REP_SYNC; ++i_) grid.sync();
#endif
    if (hi > 1000) grid.sync();
    if (IN(0)) { if (REP_SMALL) { p0_prologue(a, lds, tid, lane, wave); __syncthreads(); } p0_prologue(a, lds, tid, lane, wave); }
    SEAM(0);
#ifdef REP_XSYNC
    for (int i_ = 0; i_ < REP_XSYNC; ++i_) xcd_barrier(xbar);
#endif
    if (IN(1)) { if (REP_SMALL) rms_mod_rows(x, ctx, MT, a.in[6], MOD, 0, 1, H, lane, wave); rms_mod_rows(x, ctx, MT, a.in[6], MOD, 0, 1, H, lane, wave); }
    SEAM(1);
    if (IN(2)) { pg8::OpRouteA ra{(bf16_t*)(ws + WS_CQ), (bf16_t*)(ws + WS_CKV), (bf16_t*)(ws + WS_KR), (float*)(ws + WS_BD)};
        pg8::OpPassA2 op{ra, (bf16_t*)(ws + WS_QCX), CTX_STRIDE, (bf16_t*)(ws + WS_HALO), ML};
        pg8::Gemm g{H, WIN, MT, 6912, 1024}; PassASched S{(int)gridDim.x, (int)blockIdx.x}; pg8::EpiOp<pg8::OpPassA2> E{op};
        pg8::gemm_phase<pg8::EpiOp<pg8::OpPassA2>, PassASched, true, true>(lds, g, S, E); }
    SEAM(2);
    if (IN(3)) { if (REP_SMALL) mla_prenorm(a, lane, wave, true); mla_prenorm(a, lane, wave, false); }
    SEAM(3);
    if (IN(4)) { { pg8::OpPlain op{(bf16_t*)out, 1536}; run_gemm(lds, (const bf16_t*)(ws + WS_CQ), (const bf16_t*)(ws + WS_WUQ), ML, 1536, 384, op); }
                 { pg8::OpPlain op{(bf16_t*)(ws + WS_KVRAW), 2048}; run_gemm(lds, (const bf16_t*)(ws + WS_CKV), (const bf16_t*)(ws + WS_WUKV), MT, 2048, 256, op); } }
    SEAM(4);
    if (IN(5)) { if (REP_SMALL) mla_finish(a, lane, wave, true); mla_finish(a, lane, wave, false); }
    SEAM(5);
    if (IN(6)) {
        const att::bf16* Q = (const att::bf16*)out; const att::bf16* KF = (const att::bf16*)(ws + WS_KF); const att::bf16* KV = (const att::bf16*)(ws + WS_KVRAW); att::bf16* O = (att::bf16*)(ws + WS_O);
        const int G = gridDim.x, bx = blockIdx.x, vcu = (G % 8 == 0) ? (bx % 8) * (G / 8) + bx / 8 : bx;
        for (int rep = 0; rep < REP_ATT; ++rep)
        for (int n = vcu; n < 1024; n += G) {
            const int bh = ((n & 255) >> 5) * 4 + (n >> 8), qb = n & 31, b = bh >> 3, h = bh & 7;
            att::attn_dense_body<ATT_SDEPTH>(Q + ((size_t)b * SEQ + qb * 256) * 1536 + h * 192,
                KF + ((size_t)ML + b * CTXL) * 1536 + h * 192, KF + ((size_t)b * SEQ) * 1536 + h * 192,
                KV + ((size_t)ML + b * CTXL) * 2048 + h * 256 + 128, KV + ((size_t)b * SEQ) * 2048 + h * 256 + 128,
                O + ((size_t)b * SEQ + qb * 256) * 1024 + h * 128, CTXL + SEQ, (char*)lds_);
        }
    }
    SEAM(6);
#ifndef REP_GDNPRE
#define REP_GDNPRE 1
#endif
    for (int rep_ = 0; rep_ < REP_GDNPRE; ++rep_) {
    if (rep_ > 0) grid.sync();
    if (IN(7)) { pg8::OpSplit3 op{(bf16_t*)(ws + WS_QR), QKV_STRIDE, (bf16_t*)(ws + WS_HALO)}; run_gemm(lds, H, WIN, ML, 3072, 1024, op); }
    SEAM(7);
    if (IN(9)) { if (REP_PREP) { gdn_prep(a, lds, tid, lane, wave, true); __syncthreads(); } gdn_prep(a, lds, tid, lane, wave, false); }
    SEAM(9);
    }
    if (IN(10)) for (int rep = 0; rep < REP_CHAIN; ++rep) { if (gridDim.x >= 256) gdn_chain2(a, lds, tid, lane, wave); else gdn_chain(a, lds, tid, lane, wave); __syncthreads(); }
    SEAM(10);
    if (IN(11)) { pg8::OpZGate op{(bf16_t*)(ws + WS_Z), (bf16_t*)(ws + WS_SG)}; run_gemm(lds, H, WIN + (size_t)3072 * 1024, ML, 3072, 1024, op); }
    SEAM(11);
    if (IN(12)) { if (REP_SMALL) gdn_combine(a, tid, true); gdn_combine(a, tid, false); }
    SEAM(12);
    if (IN(13)) { pg8::OpGate<false> op{(bf16_t*)(ws + WS_Y), (const bf16_t*)(ws + WS_SG), 0}; run_gemm(lds, (const bf16_t*)(ws + WS_OF), (const bf16_t*)(ws + WS_WBG), ML, 1024, 1024, op); }
    if (IN(14)) { pg8::OpGate<true> op{(bf16_t*)(ws + WS_Y), (const bf16_t*)(ws + WS_SG), 1024}; run_gemm(lds, (const bf16_t*)(ws + WS_O), (const bf16_t*)(ws + WS_WBM), ML, 1024, 1024, op); }
    SEAM(14);
    if (IN(15)) { pg8::OpResid op{x, out, MOD + 2 * 1024}; run_gemm(lds, (const bf16_t*)(ws + WS_Y), (const bf16_t*)(ws + WS_WOUT), ML, 1024, 1024, op); }
    SEAM(15);
    if (IN(16)) { if (REP_SMALL) rms_mod_rows(out, out, ML, a.in[7], MOD, 3, 4, H, lane, wave); rms_mod_rows(out, out, ML, a.in[7], MOD, 3, 4, H, lane, wave); }
    SEAM(16);
    if (IN(17)) { pg8::OpRelu2 op{(bf16_t*)(ws + WS_HID)}; run_gemm(lds, H, (const bf16_t*)(ws + WS_WM1), ML, 4096, 1024, op);
#ifdef REP_P17
        __syncthreads(); run_gemm(lds, H, (const bf16_t*)(ws + WS_WM1), ML, 4096, 1024, op);
#endif
    }
    SEAM(17);
    if (IN(18)) { pg8::OpResid op{out, out, MOD + 5 * 1024}; run_gemm(lds, (const bf16_t*)(ws + WS_HID), (const bf16_t*)(ws + WS_WM2), ML, 1024, 4096, op); }
#undef IN
#undef SEAM
}

extern "C" void kernel_launch(void* const* d_in, const int* in_sizes, int n_in, void* d_out, int out_size, void* d_ws, size_t ws_size, hipStream_t stream) {
    static int grid = 0;
    if (grid == 0) {
        if (n_in != 24 || in_sizes[0] != ML * DM || out_size != ML * DM || ws_size < WS_END) { fprintf(stderr, "kernel_launch: unexpected shapes (n_in %d, in0 %d, out %d, ws %zu)\n", n_in, n_in > 0 ? in_sizes[0] : -1, out_size, ws_size); grid = -1; return; }
        int dev = 0, cus = 0, per_cu = 0;
        if (hipGetDevice(&dev) != hipSuccess || hipDeviceGetAttribute(&cus, hipDeviceAttributeMultiprocessorCount, dev) != hipSuccess) { grid = -1; return; }
        if (hipFuncSetAttribute((const void*)fwd_kernel, hipFuncAttributeMaxDynamicSharedMemorySize, LDS_BYTES) != hipSuccess) { fprintf(stderr, "kernel_launch: hipFuncSetAttribute failed\n"); grid = -1; return; }
        if (hipOccupancyMaxActiveBlocksPerMultiprocessor(&per_cu, (const void*)fwd_kernel, NTHR, LDS_BYTES) != hipSuccess || per_cu < 1) { fprintf(stderr, "kernel_launch: occupancy query says %d\n", per_cu); per_cu = 1; }
        (void)hipGetLastError();
        grid = cus;
    }
    if (grid < 0) return;
    if (hipMemsetAsync((char*)d_ws + WS_CTL, 0, CTL_ZERO_BYTES, stream) != hipSuccess) { fprintf(stderr, "kernel_launch: hipMemsetAsync failed\n"); return; }
    Args a{};
    for (int i = 0; i < 24; ++i) a.in[i] = (const float*)d_in[i];
    a.out = (float*)d_out; a.ws = (unsigned char*)d_ws;
#if MK_PER_PHASE
    for (int p = 0; p < N_PHASES; ++p) { a.ph_lo = p; a.ph_hi = p + 1; hipLaunchKernelGGL(fwd_kernel, dim3(grid), dim3(NTHR), LDS_BYTES, stream, a); }
#else
    a.ph_lo = 0; a.ph_hi = N_PHASES;
    void* args[] = {&a};
    const hipError_t e = hipLaunchCooperativeKernel((const void*)fwd_kernel, dim3(grid), dim3(NTHR), args, LDS_BYTES, stream);
    if (e != hipSuccess) fprintf(stderr, "kernel_launch: cooperative launch failed: %s (grid %d)\n", hipGetErrorString(e), grid);
#endif
}
```
